# Optimizing an MI355X kernel written in HIP

```python
import jax, jax.numpy as jnp
from jax import lax
import numpy as np

D_MODEL = 1024
BATCH = 8
SEQ = 2048
DEPTH = 4
DEC_BATCH = 128
DEC_SEQ = 1
PAST_LEN = 16384
PAGE_SIZE = 128

N_MIXERS = 2
N_POOL_LAYERS = (DEPTH + 1) // 2
N_GMLP_LAYERS = DEPTH // 2
POOL_WINDOWS = (2, 4, 8, 16)
POOL_GROUP = D_MODEL // len(POOL_WINDOWS)
POOL_BUF = max(POOL_WINDOWS) - 1
CHUNK = 128
GMLP_GROUPS = 8
GMLP_WIDTH = D_MODEL
GMLP_GC = GMLP_WIDTH // GMLP_GROUPS
D_FF = ((8 * D_MODEL // 3 + 255) // 256) * 256
EPS = 1e-6

kernel_name = "hybrid_pool_gmlp_adaln_decoder_step"


def _rmsnorm(x, g):
    xf = x.astype(jnp.float32)
    y = xf * lax.rsqrt(jnp.mean(xf * xf, axis=-1, keepdims=True) + EPS)
    return (y * g.astype(jnp.float32)).astype(x.dtype)


def _layernorm(x, g, b):
    xf = x.astype(jnp.float32)
    mu = jnp.mean(xf, axis=-1, keepdims=True)
    var = jnp.mean(jnp.square(xf - mu), axis=-1, keepdims=True)
    y = (xf - mu) * lax.rsqrt(var + EPS)
    return (y * g.astype(jnp.float32) + b.astype(jnp.float32)).astype(x.dtype)


def _adaln(c, w, b):
    m = jax.nn.silu(c) @ w + b
    return jnp.split(m[:, None, :], 6, axis=-1)


def _pool_mixer(h_ext, valid_ext, w_grp, scale, w_out):
    B, L, D = h_ext.shape
    T = L - POOL_BUF
    hf = h_ext.astype(jnp.float32)
    cs = jnp.pad(jnp.cumsum(hf, axis=1), ((0, 0), (1, 0), (0, 0)))
    cv = jnp.pad(jnp.cumsum(valid_ext.astype(jnp.float32), axis=1), ((0, 0), (1, 0)))
    groups = []
    for g, w in enumerate(POOL_WINDOWS):
        lo, hi = g * POOL_GROUP, (g + 1) * POOL_GROUP
        s = cs[:, POOL_BUF + 1:, lo:hi] - cs[:, POOL_BUF + 1 - w:L + 1 - w, lo:hi]
        n = cv[:, POOL_BUF + 1:] - cv[:, POOL_BUF + 1 - w:L + 1 - w]
        groups.append(s / n[..., None])
    pooled = jnp.concatenate(groups, axis=-1) - hf[:, POOL_BUF:]
    pooled = pooled.reshape(B, T, len(POOL_WINDOWS), POOL_GROUP)
    mixed = jnp.einsum('btgc,gcd->btgd', pooled, w_grp.astype(jnp.float32))
    mixed = mixed.reshape(B, T, D) * scale.astype(jnp.float32)
    return mixed.astype(h_ext.dtype) @ w_out


def _gmlp_mixer(h, w_in, ln_g, ln_b, w_s, b_s, w_out):
    B, T, D = h.shape
    uv = h @ w_in
    u, v = uv[..., :GMLP_WIDTH], uv[..., GMLP_WIDTH:]
    v = _layernorm(v, ln_g, ln_b)
    Lc = CHUNK if T >= CHUNK else T
    n_chunks = T // Lc
    vc = v.reshape(B, n_chunks, Lc, GMLP_GROUPS, GMLP_GC)
    ws = jnp.tril(w_s[:, :Lc, :Lc])
    mixed = jnp.einsum('gts,bcsgd->bctgd', ws, vc) + b_s[:, :Lc].T[None, None, :, :, None]
    out = u * mixed.reshape(B, T, GMLP_WIDTH)
    return out @ w_out, v


def _run_group(x, c, pool_hist, pool_valid,
               w_ada, b_ada, norm_mix, norm_ffn, norm_final,
               pool_w_grp, pool_scale, pool_w_out,
               gmlp_w_in, gmlp_ln_g, gmlp_ln_b, gmlp_w_s, gmlp_b_s, gmlp_w_out,
               ffn_w_gate, ffn_w_up, ffn_w_down):
    new_pool, new_v = [], []
    for i in range(DEPTH):
        sh1, sc1, g1, sh2, sc2, g2 = _adaln(c, w_ada[i], b_ada[i])
        h = _rmsnorm(x, norm_mix[i]) * (1 + sc1) + sh1
        if i % N_MIXERS == 0:
            j = i // N_MIXERS
            h_ext = jnp.concatenate([pool_hist[j].astype(h.dtype), h], axis=1)
            out = _pool_mixer(h_ext, pool_valid, pool_w_grp[j], pool_scale[j], pool_w_out[j])
            new_pool.append(h_ext[:, -POOL_BUF:])
        else:
            j = i // N_MIXERS
            out, v = _gmlp_mixer(h, gmlp_w_in[j], gmlp_ln_g[j], gmlp_ln_b[j],
                                 gmlp_w_s[j], gmlp_b_s[j], gmlp_w_out[j])
            new_v.append(v)
        x = x + g1 * out
        h = _rmsnorm(x, norm_ffn[i]) * (1 + sc2) + sh2
        ff = (jax.nn.silu(h @ ffn_w_gate[i]) * (h @ ffn_w_up[i])) @ ffn_w_down[i]
        x = x + g2 * ff
    return _rmsnorm(x, norm_final), jnp.stack(new_pool), jnp.stack(new_v)


def setup_inputs(seed: int = 0) -> dict:
    key = jax.random.key(seed)
    ks = jax.random.split(key, 24)
    D, F = D_MODEL, D_FF
    nrm = lambda k, shape, s: jax.random.normal(k, shape, jnp.float32) * s
    return {
        "x_prompt": nrm(ks[0], (BATCH, SEQ, D), 1.0),
        "x_sample": nrm(ks[1], (DEC_BATCH, DEC_SEQ, D), 1.0),
        "state_pool": nrm(ks[2], (N_POOL_LAYERS, DEC_BATCH, POOL_BUF, D), 1.0),
        "c_prompt": nrm(ks[3], (BATCH, D), 1.0),
        "c_sample": nrm(ks[4], (DEC_BATCH, D), 1.0),
        "w_ada": nrm(ks[5], (DEPTH, D, 6 * D), 0.5 * D ** -0.5),
        "b_ada": nrm(ks[6], (DEPTH, 6 * D), 0.02),
        "norm_mix": 1.0 + nrm(ks[7], (DEPTH, D), 0.05),
        "norm_ffn": 1.0 + nrm(ks[8], (DEPTH, D), 0.05),
        "norm_final": 1.0 + nrm(ks[9], (D,), 0.05),
        "pool_w_grp": nrm(ks[10], (N_POOL_LAYERS, len(POOL_WINDOWS), POOL_GROUP, POOL_GROUP), POOL_GROUP ** -0.5),
        "pool_scale": 1.0 + nrm(ks[11], (N_POOL_LAYERS, D), 0.1),
        "pool_w_out": nrm(ks[12], (N_POOL_LAYERS, D, D), D ** -0.5),
        "gmlp_w_in": nrm(ks[13], (N_GMLP_LAYERS, D, 2 * GMLP_WIDTH), D ** -0.5),
        "gmlp_ln_g": 1.0 + nrm(ks[14], (N_GMLP_LAYERS, GMLP_WIDTH), 0.05),
        "gmlp_ln_b": nrm(ks[15], (N_GMLP_LAYERS, GMLP_WIDTH), 0.02),
        "gmlp_w_s": nrm(ks[16], (N_GMLP_LAYERS, GMLP_GROUPS, CHUNK, CHUNK), CHUNK ** -0.5),
        "gmlp_b_s": 1.0 + nrm(ks[17], (N_GMLP_LAYERS, GMLP_GROUPS, CHUNK), 0.05),
        "gmlp_w_out": nrm(ks[18], (N_GMLP_LAYERS, GMLP_WIDTH, D), GMLP_WIDTH ** -0.5),
        "ffn_w_gate": nrm(ks[19], (DEPTH, D, F), D ** -0.5),
        "ffn_w_up": nrm(ks[20], (DEPTH, D, F), D ** -0.5),
        "ffn_w_down": nrm(ks[21], (DEPTH, F, D), F ** -0.5),
    }


def reference(x_prompt, x_sample, state_pool, c_prompt, c_sample,
              w_ada, b_ada, norm_mix, norm_ffn, norm_final,
              pool_w_grp, pool_scale, pool_w_out,
              gmlp_w_in, gmlp_ln_g, gmlp_ln_b, gmlp_w_s, gmlp_b_s, gmlp_w_out,
              ffn_w_gate, ffn_w_up, ffn_w_down):
    weights = (w_ada, b_ada, norm_mix, norm_ffn, norm_final,
               pool_w_grp, pool_scale, pool_w_out,
               gmlp_w_in, gmlp_ln_g, gmlp_ln_b, gmlp_w_s, gmlp_b_s, gmlp_w_out,
               ffn_w_gate, ffn_w_up, ffn_w_down)
    B, S, D = x_prompt.shape
    hist_p = jnp.zeros((N_POOL_LAYERS, B, POOL_BUF, D), x_prompt.dtype)
    valid_p = jnp.concatenate([jnp.zeros((1, POOL_BUF), jnp.float32),
                               jnp.ones((1, S), jnp.float32)], axis=1)
    y_prompt, new_pool_prompt, _ = _run_group(x_prompt, c_prompt, hist_p, valid_p, *weights)
    T = x_sample.shape[1]
    valid_s = jnp.ones((1, POOL_BUF + T), jnp.float32)
    y_sample, new_pool_sample, new_chunk_v_sample = _run_group(
        x_sample, c_sample, state_pool, valid_s, *weights)
    return (y_prompt, y_sample, new_pool_prompt, new_pool_sample, new_chunk_v_sample)
```

```cpp
#include <hip/hip_runtime.h>
#include <hip/hip_cooperative_groups.h>
#include <cstdio>
namespace cg = cooperative_groups;

#define LAS __attribute__((address_space(3)))
typedef unsigned short bf16_t;
typedef short bf16x8 __attribute__((ext_vector_type(8)));
typedef float f32x4 __attribute__((ext_vector_type(4)));
typedef float f32x2 __attribute__((ext_vector_type(2)));
typedef unsigned u32x4 __attribute__((ext_vector_type(4)));
typedef unsigned u32x2 __attribute__((ext_vector_type(2)));

constexpr int D = 1024, NPR = 16384, NSM = 128, MR = NPR + NSM  , MP = 16640  , FF = 2816, SEQ = 2048;
constexpr int NCOND = 136, MODW = 4 * 6 * D  ;
constexpr float EPS = 1e-6f;
constexpr size_t O_YP = 0, O_YS = (size_t)NPR * D, O_NPP = O_YS + (size_t)NSM * D, O_NPS = O_NPP + (size_t)2 * 8 * 15 * D, O_NV = O_NPS + (size_t)2 * 128 * 15 * D;
constexpr size_t MiB = 1u << 20;
constexpr size_t WS_WADA = 1 * MiB;
constexpr size_t WS_WGU = WS_WADA + (size_t)MODW * D * 2;
constexpr size_t WS_WDN = WS_WGU + (size_t)4 * 2 * FF * D * 2;
constexpr size_t WS_WIN = WS_WDN + (size_t)4 * D * FF * 2;
constexpr size_t WS_WGO = WS_WIN + (size_t)2 * 2 * D * D * 2;
constexpr size_t WS_WPO = WS_WGO + (size_t)2 * D * D * 2;
constexpr size_t WS_WPG = WS_WPO + (size_t)2 * D * D * 2;
constexpr size_t WS_WSP = WS_WPG + (size_t)2 * 4 * 256 * 256 * 2;
constexpr size_t WS_SC = WS_WSP + (size_t)2 * 8 * 128 * 128 * 2;
constexpr size_t WS_MOD = WS_SC + (size_t)256 * D * 2;
constexpr size_t WS_H = WS_MOD + (size_t)NCOND * MODW * 4;
constexpr size_t WS_B2 = WS_H + (size_t)MP * D * 2;
constexpr size_t WS_ACT = WS_B2 + (size_t)MP * D * 2;
constexpr size_t WS_U = WS_ACT, WS_V = WS_ACT + (size_t)MP * D * 2;
constexpr size_t WS_RSS = WS_ACT + (size_t)MP * FF * 2;
constexpr int RSTR = NPR * 4 + NSM * 32;
constexpr size_t WS_SHB = WS_RSS + (size_t)6 * RSTR * 4;
constexpr size_t WS_CBG = WS_SHB + (size_t)6 * 256 * D * 2;
constexpr size_t WS_CBI = WS_CBG + (size_t)4 * NCOND * 2 * FF * 4;
constexpr size_t WS_WEF = WS_CBI + (size_t)2 * NCOND * 2 * D * 4;
constexpr size_t WS_XB = WS_WEF + (size_t)2 * D * D * 2;
constexpr size_t WS_END = WS_XB + (size_t)MP * D * 2;
constexpr int LDS_BYTES = 147456;

__device__ __forceinline__ unsigned cvt_pk_bf16(float lo, float hi) { unsigned r; asm volatile("v_cvt_pk_bf16_f32 %0, %1, %2" : "=v"(r) : "v"(lo), "v"(hi)); return r; }
__device__ __forceinline__ float bf_lo(unsigned w) { return __uint_as_float(w << 16); }
__device__ __forceinline__ float bf_hi(unsigned w) { return __uint_as_float(w & 0xffff0000u); }
template <int CTRL> __device__ __forceinline__ float dpp_f(float v) { return __int_as_float(__builtin_amdgcn_mov_dpp(__float_as_int(v), CTRL, 0xf, 0xf, true)); }
__device__ __forceinline__ float wave_sum(float v) {
    v += dpp_f<0xB1>(v);
    v += dpp_f<0x4E>(v);
    v += dpp_f<0x141>(v);
    v += dpp_f<0x140>(v);
    const int iv = __float_as_int(v);
    return (__int_as_float(__builtin_amdgcn_readlane(iv, 0)) + __int_as_float(__builtin_amdgcn_readlane(iv, 16))) + (__int_as_float(__builtin_amdgcn_readlane(iv, 32)) + __int_as_float(__builtin_amdgcn_readlane(iv, 48)));
}
__device__ __forceinline__ int cond_of(int row) { int c = row < NPR ? (row >> 11) : 8 + (row - NPR); return c > NCOND - 1 ? NCOND - 1 : c; }
__device__ __forceinline__ float silu_f(float g) { return g * __builtin_amdgcn_rcpf(1.0f + __expf(-g)); }

namespace pg8 {
constexpr int BM = 256, BK = 64, HALF = 128, HTB = HALF * BK * 2, STAGE_BYTES = 8 * HTB, NXCD = 8, WGM = 8;
__device__ __forceinline__ int lds_byte(int r, int c) { const int st = (r >> 4) * 2 + (c >> 5), rr = r & 15, cc = c & 31, ob = rr * 64 + cc * 2; return st * 1024 + (ob ^ (((ob >> 9) & 1) << 5)); }
__device__ __forceinline__ void stage_rc(int b, int& R, int& C) { const int st = b / 1024, sb = b % 1024, swz = sb ^ (((sb >> 9) & 1) << 5); R = (st >> 1) * 16 + swz / 64; C = (st & 1) * 32 + (swz % 64) / 2; }
__device__ __forceinline__ int perm32(int rho) { const int n = rho >> 4, i = rho & 15; return 8 * (i >> 2) + 4 * n + (i & 3); }

struct Unit { int pm, pn, idx; };
struct Gemm { const bf16_t* A; const bf16_t* Bt; int M, N, K, lda, a_pn_step; };

struct StaticOrder {
    int nM, nN, nwg, G, c;
    __device__ void init(int M, int N, int G_, int c_) { nM = M / BM; nN = N / BM; nwg = nM * nN; G = G_; c = c_; }
    __device__ bool next(int i, Unit& u) const {
        const long L = (long)i * G + c; if (L >= nwg) return false;
        int wgid = (int)L; { const int q = nwg / NXCD, r = nwg % NXCD, xcd = wgid % NXCD, off = wgid / NXCD; wgid = (xcd < r ? xcd * (q + 1) : r * (q + 1) + (xcd - r) * q) + off; }
        const int nig = WGM * nN, gid = wgid / nig, fm = gid * WGM, gsz = (nM - fm) < WGM ? (nM - fm) : WGM;
        u.pm = fm + ((wgid % nig) % gsz); u.pn = (wgid % nig) / gsz; u.idx = i; return true;
    }
};


struct EpiAda {
    static constexpr bool PERM = false, AFTER_DRAIN = false;
    float* C; const float* bias; bf16_t* shb;
    __device__ __forceinline__ void operator()(const f32x4 (&acc)[2][2][4][2], const Unit& u, int wr, int wc, int fr, int fq) const {
        const int row0 = u.pm * BM + wr * 64 + fr, col0 = u.pn * BM + wc * 32 + 4 * fq;
        const int tc = u.pn * BM, l = tc / (6 * D), chunk = (tc % (6 * D)) >> 10, cc0 = (tc & (D - 1)) + wc * 32 + 4 * fq;
        const int shidx = chunk == 3 ? l : ((chunk == 0 && (l & 1)) ? 4 + (l >> 1) : -1);
#pragma unroll
        for (int ai = 0; ai < 2; ++ai)
#pragma unroll
            for (int m = 0; m < 4; ++m) { const int row = row0 + ai * HALF + m * 16;
#pragma unroll
                for (int bj = 0; bj < 2; ++bj)
#pragma unroll
                    for (int n = 0; n < 2; ++n) { const f32x4 v = acc[ai][bj][m][n] + *(const f32x4*)(bias + col0 + bj * HALF + n * 16);
                        if (row < NCOND) *(f32x4*)(C + (size_t)row * MODW + col0 + bj * HALF + n * 16) = v;
                        if (shidx >= 0) { u32x2 w; w.x = cvt_pk_bf16(v[0], v[1]); w.y = cvt_pk_bf16(v[2], v[3]); *(u32x2*)(shb + ((size_t)shidx * 256 + row) * D + cc0 + bj * HALF + n * 16) = w; } } }
    }
};
struct EpiCbw {
    static constexpr bool PERM = false, AFTER_DRAIN = false;
    float* C; int ldc;
    __device__ __forceinline__ void operator()(const f32x4 (&acc)[2][2][4][2], const Unit& u, int wr, int wc, int fr, int fq) const {
        const int row0 = u.pm * BM + wr * 64 + fr, col0 = u.pn * BM + wc * 32 + 4 * fq;
#pragma unroll
        for (int ai = 0; ai < 2; ++ai)
#pragma unroll
            for (int m = 0; m < 4; ++m) { const int row = row0 + ai * HALF + m * 16;
                if (row < NCOND) {
#pragma unroll
                    for (int bj = 0; bj < 2; ++bj)
#pragma unroll
                        for (int n = 0; n < 2; ++n) *(f32x4*)(C + (size_t)row * ldc + col0 + bj * HALF + n * 16) = acc[ai][bj][m][n]; } }
    }
};
template <bool XA>
struct EpiResidT {
    static constexpr bool PERM = true, AFTER_DRAIN = XA;
    const float* xin32; const bf16_t* xinb; bf16_t* xb; const float* modg;
    bf16_t* xa; const float* wnn; const float* scn; float* rowss;
    __device__ __forceinline__ void body(const f32x4 (&acc)[2][2][4][2], const Unit& u, int wr, int wc, int fr, int fq, LAS float* P) const {
        const int row0 = u.pm * BM + wr * 64 + fr, col0 = u.pn * BM + wc * 32 + 8 * fq;
        const float* gp = modg + (size_t)(u.pm >> 3) * MODW + col0;
        f32x4 gv[2][2], ca[2][2];
#pragma unroll
        for (int bj = 0; bj < 2; ++bj)
#pragma unroll
            for (int n = 0; n < 2; ++n) { gv[bj][n] = *(const f32x4*)(gp + bj * HALF + 4 * n);
                if (XA) ca[bj][n] = *(const f32x4*)(wnn + col0 + bj * HALF + 4 * n) * (1.0f + *(const f32x4*)(scn + (size_t)(u.pm >> 3) * MODW + col0 + bj * HALF + 4 * n)); }
#pragma unroll
        for (int ai = 0; ai < 2; ++ai)
#pragma unroll
            for (int mp = 0; mp < 2; ++mp) {
                f32x4 xv[2][2][2];
                if (xin32) {
#pragma unroll
                    for (int mm = 0; mm < 2; ++mm) { const float* xp = xin32 + (size_t)(row0 + ai * HALF + (2 * mp + mm) * 16) * D + col0;
#pragma unroll
                        for (int bj = 0; bj < 2; ++bj)
#pragma unroll
                            for (int n = 0; n < 2; ++n) xv[mm][bj][n] = *(const f32x4*)(xp + bj * HALF + 4 * n); }
                } else {
                    u32x4 xw[2][2];
#pragma unroll
                    for (int mm = 0; mm < 2; ++mm)
#pragma unroll
                        for (int bj = 0; bj < 2; ++bj) xw[mm][bj] = *(const u32x4*)(xinb + (size_t)(row0 + ai * HALF + (2 * mp + mm) * 16) * D + col0 + bj * HALF);
#pragma unroll
                    for (int mm = 0; mm < 2; ++mm)
#pragma unroll
                        for (int bj = 0; bj < 2; ++bj) { xv[mm][bj][0] = (f32x4){bf_lo(xw[mm][bj].x), bf_hi(xw[mm][bj].x), bf_lo(xw[mm][bj].y), bf_hi(xw[mm][bj].y)};
                            xv[mm][bj][1] = (f32x4){bf_lo(xw[mm][bj].z), bf_hi(xw[mm][bj].z), bf_lo(xw[mm][bj].w), bf_hi(xw[mm][bj].w)}; }
                }
                __builtin_amdgcn_sched_barrier(0);
#pragma unroll
                for (int mm = 0; mm < 2; ++mm) { const size_t ro = (size_t)(row0 + ai * HALF + (2 * mp + mm) * 16) * D + col0; float sq = 0.f;
#pragma unroll
                    for (int bj = 0; bj < 2; ++bj) {
                        const f32x4 x0 = xv[mm][bj][0] + gv[bj][0] * acc[ai][bj][2 * mp + mm][0], x1 = xv[mm][bj][1] + gv[bj][1] * acc[ai][bj][2 * mp + mm][1];
                        u32x4 w; w.x = cvt_pk_bf16(x0[0], x0[1]); w.y = cvt_pk_bf16(x0[2], x0[3]); w.z = cvt_pk_bf16(x1[0], x1[1]); w.w = cvt_pk_bf16(x1[2], x1[3]);
                        *(u32x4*)(xb + ro + bj * HALF) = w;
                        if (XA) { sq += ((x0[0] * x0[0] + x0[1] * x0[1]) + (x0[2] * x0[2] + x0[3] * x0[3])) + ((x1[0] * x1[0] + x1[1] * x1[1]) + (x1[2] * x1[2] + x1[3] * x1[3]));
                            const f32x4 h0 = x0 * ca[bj][0], h1 = x1 * ca[bj][1];
                            u32x4 hw; hw.x = cvt_pk_bf16(h0[0], h0[1]); hw.y = cvt_pk_bf16(h0[2], h0[3]); hw.z = cvt_pk_bf16(h1[0], h1[1]); hw.w = cvt_pk_bf16(h1[2], h1[3]);
                            *(u32x4*)(xa + ro + bj * HALF) = hw; } }
                    if (XA) { sq += __int_as_float(__builtin_amdgcn_ds_swizzle(__float_as_int(sq), 0x401F));
                        if ((fq & 1) == 0) P[(ai * HALF + wr * 64 + (2 * mp + mm) * 16 + fr) * 8 + wc * 2 + (fq >> 1)] = sq; } }
                __builtin_amdgcn_sched_barrier(0);
            }
    }
    __device__ __forceinline__ void operator()(const f32x4 (&acc)[2][2][4][2], const Unit& u, int wr, int wc, int fr, int fq) const { body(acc, u, wr, wc, fr, fq, nullptr); }
    __device__ __forceinline__ void fused(const f32x4 (&acc)[2][2][4][2], const Unit& u, int wr, int wc, int fr, int fq, LAS unsigned char* lds, int tid) const {
        LAS float* P = (LAS float*)lds;
        body(acc, u, wr, wc, fr, fq, P);
        __syncthreads();
        if (tid < 256) { const f32x4 p0 = *(const LAS f32x4*)(P + tid * 8), p1 = *(const LAS f32x4*)(P + tid * 8 + 4);
            rowss[(size_t)(u.pm * BM + tid) * 4 + u.pn] = ((p0[0] + p0[1]) + (p0[2] + p0[3])) + ((p1[0] + p1[1]) + (p1[2] + p1[3])); }
        __syncthreads();
    }
};
struct EpiBf16 {
    static constexpr bool PERM = true, AFTER_DRAIN = false;
    bf16_t* O; bf16_t* O2; const float* scale; const float* rowss; const float* cbw; int ldcb;
    __device__ __forceinline__ void operator()(const f32x4 (&acc)[2][2][4][2], const Unit& u, int wr, int wc, int fr, int fq) const {
        const int row0 = u.pm * BM + wr * 64 + fr; bf16_t* base = u.pn >= 4 ? O2 : O; const int col0 = (u.pn & 3) * BM + wc * 32 + 8 * fq;
        f32x4 sv[2][2], bv[2][2];
#pragma unroll
        for (int bj = 0; bj < 2; ++bj)
#pragma unroll
            for (int n = 0; n < 2; ++n) { sv[bj][n] = scale ? *(const f32x4*)(scale + col0 + bj * HALF + 4 * n) : (f32x4){1.f, 1.f, 1.f, 1.f};
                bv[bj][n] = rowss ? *(const f32x4*)(cbw + (size_t)(u.pm >> 3) * ldcb + u.pn * BM + wc * 32 + 8 * fq + bj * HALF + 4 * n) : (f32x4){0.f, 0.f, 0.f, 0.f}; }
        float rs[2][4];
#pragma unroll
        for (int ai = 0; ai < 2; ++ai)
#pragma unroll
            for (int m = 0; m < 4; ++m) { rs[ai][m] = 1.0f;
                if (rowss) { const f32x4 p = *(const f32x4*)(rowss + (size_t)(row0 + ai * HALF + m * 16) * 4); rs[ai][m] = __builtin_amdgcn_rsqf(((p[0] + p[1]) + (p[2] + p[3])) * (1.f / D) + EPS); } }
        __builtin_amdgcn_sched_barrier(0);
#pragma unroll
        for (int ai = 0; ai < 2; ++ai)
#pragma unroll
            for (int m = 0; m < 4; ++m) { const int row = row0 + ai * HALF + m * 16; bf16_t* rowp = base + (size_t)row * D + col0;
#pragma unroll
                for (int bj = 0; bj < 2; ++bj) { const f32x4 v0 = acc[ai][bj][m][0] * sv[bj][0] * rs[ai][m] + bv[bj][0], v1 = acc[ai][bj][m][1] * sv[bj][1] * rs[ai][m] + bv[bj][1];
                    u32x4 w; w.x = cvt_pk_bf16(v0[0], v0[1]); w.y = cvt_pk_bf16(v0[2], v0[3]); w.z = cvt_pk_bf16(v1[0], v1[1]); w.w = cvt_pk_bf16(v1[2], v1[3]);
                    *(u32x4*)(rowp + bj * HALF) = w; } }
    }
};
constexpr int TAB_OFF = 131072 + 1024, TAB_STRIDE = 2048, TAB_MAX = 7;
struct EpiSwiGLU {
    static constexpr bool PERM = true, AFTER_DRAIN = false;
    bf16_t* O; LAS unsigned char* lds;
    __device__ __forceinline__ void operator()(const f32x4 (&acc)[2][2][4][2], const Unit& u, int wr, int wc, int fr, int fq) const {
        const int row0 = u.pm * BM + wr * 64 + fr, col0 = u.pn * HALF + wc * 32 + 8 * fq;
        const LAS float* T = (const LAS float*)(lds + TAB_OFF + u.idx * TAB_STRIDE);
        const f32x4 cg0 = *(const LAS f32x4*)(T + 256 + wc * 32 + 8 * fq), cg1 = *(const LAS f32x4*)(T + 256 + wc * 32 + 8 * fq + 4), cu0 = *(const LAS f32x4*)(T + 256 + HALF + wc * 32 + 8 * fq), cu1 = *(const LAS f32x4*)(T + 256 + HALF + wc * 32 + 8 * fq + 4);
#pragma unroll
        for (int ai = 0; ai < 2; ++ai)
#pragma unroll
            for (int m = 0; m < 4; ++m) { const int row = row0 + ai * HALF + m * 16; bf16_t* rowp = O + (size_t)row * FF + col0;
                const float r1 = T[ai * HALF + wr * 64 + m * 16 + fr];
                const f32x4 g0 = acc[ai][0][m][0] * r1 + cg0, g1 = acc[ai][0][m][1] * r1 + cg1, u0 = acc[ai][1][m][0] * r1 + cu0, u1 = acc[ai][1][m][1] * r1 + cu1;
                u32x4 w; w.x = cvt_pk_bf16(silu_f(g0[0]) * u0[0], silu_f(g0[1]) * u0[1]); w.y = cvt_pk_bf16(silu_f(g0[2]) * u0[2], silu_f(g0[3]) * u0[3]);
                w.z = cvt_pk_bf16(silu_f(g1[0]) * u1[0], silu_f(g1[1]) * u1[1]); w.w = cvt_pk_bf16(silu_f(g1[2]) * u1[2], silu_f(g1[3]) * u1[3]);
                *(u32x4*)rowp = w; }
    }
};
__device__ __forceinline__ void stage_swiglu_tables(LAS unsigned char* lds, const StaticOrder& S, const float* rowss, const float* cbw) {
    int tid = threadIdx.x; asm volatile("" : "+v"(tid));
    f32x4 p[TAB_MAX]; float c[TAB_MAX]; bool ok[TAB_MAX];
#pragma unroll
    for (int i = 0; i < TAB_MAX; ++i) { Unit u; ok[i] = S.next(i, u); p[i] = (f32x4){1.f, 1.f, 1.f, 1.f}; c[i] = 0.f;
        if (ok[i]) { if (tid < 256) p[i] = *(const f32x4*)(rowss + (size_t)(u.pm * BM + tid) * 4); else c[i] = cbw[(size_t)(u.pm >> 3) * (2 * FF) + u.pn * BM + (tid - 256)]; } }
    __builtin_amdgcn_sched_barrier(0);
#pragma unroll
    for (int i = 0; i < TAB_MAX; ++i) if (ok[i]) ((LAS float*)(lds + TAB_OFF + i * TAB_STRIDE))[tid] = tid < 256 ? __builtin_amdgcn_rsqf(((p[i][0] + p[i][1]) + (p[i][2] + p[i][3])) * (1.f / D) + EPS) : c[i];
    __syncthreads();
}

template <class Epi>
__device__ __forceinline__ void gemm_phase(LAS unsigned char* lds, const Gemm g, const StaticOrder& S, const Epi& E) {
    int tid_o = threadIdx.x; asm volatile("" : "+v"(tid_o));
    const int tid = tid_o, wid = __builtin_amdgcn_readfirstlane(tid >> 6), lane = tid & 63, wr = wid >> 2, wc = wid & 3, fr = lane & 15, fq = lane >> 4;
    const int K = g.K, nt = K / BK, lda = g.lda;
    unsigned voffA[2], voffB[2];
#pragma unroll
    for (int i = 0; i < 2; ++i) { int R, C; stage_rc(tid * 16 + i * 8192, R, C); const int Rb = Epi::PERM ? ((R & ~31) + perm32(R & 31)) : R;
        voffA[i] = (unsigned)(R * lda + C) * 2u; voffB[i] = (unsigned)(Rb * K + C) * 2u; }
    const size_t kstep = (size_t)(BK * 2);
    const size_t hstepA = (size_t)HALF * lda * 2, hstepB = (size_t)HALF * K * 2;
    const size_t tstepA = 2 * hstepA, tstepB = 2 * hstepB;
    const unsigned ldsw = (unsigned)wid * 1024u;
    const int aoff = lds_byte(wr * 64 + fr, fq * 8), boff = lds_byte(wc * 32 + fr, fq * 8);
#define PG8_SA(b, h) (((b) * 2 + (h)) * HTB)
#define PG8_SB(b, h) ((4 + (b) * 2 + (h)) * HTB)
#define PG8_STAGE(bufoff, gbase, voff) do { _Pragma("unroll") for (int _i = 0; _i < 2; ++_i) \
        __builtin_amdgcn_global_load_lds((const unsigned*)((const char*)(gbase) + (voff)[_i]), (LAS unsigned*)(lds + (bufoff) + ldsw + _i * 8192), 16, 0, 0); } while (0)
#define PG8_LDA(dst, b, h) do { _Pragma("unroll") for (int m = 0; m < 4; ++m) _Pragma("unroll") for (int k = 0; k < 2; ++k) dst[m][k] = *(const LAS bf16x8*)(lds + PG8_SA(b, h) + aoff + m * 2048 + k * 1024); } while (0)
#define PG8_LDB(dst, b, h) do { _Pragma("unroll") for (int n = 0; n < 2; ++n) _Pragma("unroll") for (int k = 0; k < 2; ++k) dst[n][k] = *(const LAS bf16x8*)(lds + PG8_SB(b, h) + boff + n * 2048 + k * 1024); } while (0)
#define PG8_MMA(ai, bj, At, Bt) do { __builtin_amdgcn_s_setprio(1); _Pragma("unroll") for (int m = 0; m < 4; ++m) _Pragma("unroll") for (int n = 0; n < 2; ++n) _Pragma("unroll") for (int k = 0; k < 2; ++k) \
        acc[ai][bj][m][n] = __builtin_amdgcn_mfma_f32_16x16x32_bf16(Bt[n][k], At[m][k], acc[ai][bj][m][n], 0, 0, 0); __builtin_amdgcn_s_setprio(0); } while (0)
#define PG8_WAIT_V(n) asm volatile("s_waitcnt vmcnt(" #n ")" ::: "memory")
#define PG8_WAIT_L(n) asm volatile("s_waitcnt lgkmcnt(" #n ")" ::: "memory")
#define PG8_BAR __builtin_amdgcn_s_barrier()
#define PG8_SCHED __builtin_amdgcn_sched_barrier(0)
    Unit cur, nxt; int ui = 0;
    if (!S.next(0, cur)) return;
    f32x4 acc[2][2][4][2];
#pragma unroll
    for (int a = 0; a < 2; ++a)
#pragma unroll
        for (int b = 0; b < 2; ++b)
#pragma unroll
            for (int m = 0; m < 4; ++m)
#pragma unroll
                for (int n = 0; n < 2; ++n) acc[a][b][m][n] = (f32x4){0.f, 0.f, 0.f, 0.f};
    bf16x8 At[4][2], B0[2][2], B1[2][2];
    const char* cA = (const char*)g.A + (size_t)cur.pm * tstepA + (size_t)cur.pn * g.a_pn_step * 2; const char* cB = (const char*)g.Bt + (size_t)cur.pn * tstepB;
    PG8_STAGE(PG8_SB(0, 0), cB, voffB); PG8_STAGE(PG8_SA(0, 0), cA, voffA); PG8_STAGE(PG8_SB(0, 1), cB + hstepB, voffB); PG8_STAGE(PG8_SA(0, 1), cA + hstepA, voffA);
    if (wr == 1) PG8_BAR;
    PG8_WAIT_V(4); PG8_BAR;
    PG8_STAGE(PG8_SB(1, 0), cB + kstep, voffB); PG8_STAGE(PG8_SA(1, 0), cA + kstep, voffA); PG8_STAGE(PG8_SB(1, 1), cB + hstepB + kstep, voffB);
    PG8_WAIT_V(6); PG8_BAR;
    for (;;) {
        const bool has_next = S.next(ui + 1, nxt);
        const char* nA = has_next ? (const char*)g.A + (size_t)nxt.pm * tstepA + (size_t)nxt.pn * g.a_pn_step * 2 : cA; const char* nB = has_next ? (const char*)g.Bt + (size_t)nxt.pn * tstepB : cB;
        for (int t = 0; t < nt; t += 2) {
            const bool last = (t == nt - 2);
            const char* a1 = cA + (size_t)(t + 1) * kstep;
            const char* a2 = last ? nA : cA + (size_t)(t + 2) * kstep; const char* b2 = last ? nB : cB + (size_t)(t + 2) * kstep;
            const char* a3 = a2 + kstep; const char* b3 = b2 + kstep;
            PG8_LDB(B0, 0, 0); PG8_SCHED; PG8_LDA(At, 0, 0); PG8_STAGE(PG8_SA(1, 1), a1 + hstepA, voffA);
            PG8_WAIT_L(8); PG8_BAR; PG8_WAIT_L(0); PG8_MMA(0, 0, At, B0); PG8_BAR; PG8_SCHED;
            PG8_LDB(B1, 0, 1); PG8_STAGE(PG8_SB(0, 0), b2, voffB);
            PG8_BAR; PG8_WAIT_L(0); PG8_MMA(0, 1, At, B1); PG8_BAR;
            PG8_LDA(At, 0, 1); PG8_STAGE(PG8_SA(0, 0), a2, voffA);
            PG8_BAR; PG8_WAIT_L(0); PG8_MMA(1, 0, At, B0); PG8_BAR; PG8_SCHED;
            PG8_STAGE(PG8_SB(0, 1), b2 + hstepB, voffB);
            PG8_WAIT_V(6); PG8_BAR; PG8_MMA(1, 1, At, B1); PG8_BAR;
            PG8_LDB(B0, 1, 0); PG8_SCHED; PG8_LDA(At, 1, 0); PG8_STAGE(PG8_SA(0, 1), a2 + hstepA, voffA);
            PG8_WAIT_L(8); PG8_BAR; PG8_WAIT_L(0); PG8_MMA(0, 0, At, B0); PG8_BAR; PG8_SCHED;
            PG8_LDB(B1, 1, 1); PG8_STAGE(PG8_SB(1, 0), b3, voffB);
            PG8_BAR; PG8_WAIT_L(0); PG8_MMA(0, 1, At, B1); PG8_BAR;
            PG8_LDA(At, 1, 1); PG8_STAGE(PG8_SA(1, 0), a3, voffA);
            PG8_BAR; PG8_WAIT_L(0); PG8_MMA(1, 0, At, B0); PG8_BAR; PG8_SCHED;
            PG8_STAGE(PG8_SB(1, 1), b3 + hstepB, voffB);
            PG8_WAIT_V(6); PG8_BAR; PG8_MMA(1, 1, At, B1); PG8_BAR;
        }
        if constexpr (!Epi::AFTER_DRAIN) E(acc, cur, wr, wc, fr, fq);
        if (!has_next) break;
#pragma unroll
        for (int a = 0; a < 2; ++a)
#pragma unroll
            for (int b = 0; b < 2; ++b)
#pragma unroll
                for (int m = 0; m < 4; ++m)
#pragma unroll
                    for (int n = 0; n < 2; ++n) acc[a][b][m][n] = (f32x4){0.f, 0.f, 0.f, 0.f};
        cur = nxt; cA = nA; cB = nB; ++ui;
    }
    PG8_WAIT_V(0);
    if (wr == 0) PG8_BAR;
    PG8_BAR;
    if constexpr (Epi::AFTER_DRAIN) E.fused(acc, cur, wr, wc, fr, fq, lds, tid);
#undef PG8_SA
#undef PG8_SB
#undef PG8_STAGE
#undef PG8_LDA
#undef PG8_LDB
#undef PG8_MMA
#undef PG8_WAIT_V
#undef PG8_WAIT_L
#undef PG8_BAR
#undef PG8_SCHED
}
}


struct Skinny { const bf16_t* A; int lda, a_grp; const bf16_t* Bt; int K, ntask, first, navail, bx; };
struct SkResid { const float* xin32; const bf16_t* xinb; bf16_t* xb; const float* modg;
    bf16_t* xa; const float* wnn; const float* scn; float* rowss;
    __device__ __forceinline__ void operator()(const f32x4& r, const f32x4&, int row, int col) const {
        const int cnd = 8 + row - NPR; const f32x4 gv = *(const f32x4*)(modg + (size_t)cnd * MODW + col);
        f32x4 xo;
        if (xin32) xo = *(const f32x4*)(xin32 + (size_t)(row - NPR) * D + col);
        else { const u32x2 w = *(const u32x2*)(xinb + (size_t)row * D + col); xo = (f32x4){bf_lo(w.x), bf_hi(w.x), bf_lo(w.y), bf_hi(w.y)}; }
        const f32x4 xn = xo + gv * r;
        { u32x2 w; w.x = cvt_pk_bf16(xn[0], xn[1]); w.y = cvt_pk_bf16(xn[2], xn[3]); *(u32x2*)(xb + (size_t)row * D + col) = w; }
        if (xa) { const f32x4 hv = xn * (*(const f32x4*)(wnn + col) * (1.0f + *(const f32x4*)(scn + (size_t)cnd * MODW + col)));
            u32x2 w; w.x = cvt_pk_bf16(hv[0], hv[1]); w.y = cvt_pk_bf16(hv[2], hv[3]); *(u32x2*)(xa + (size_t)row * D + col) = w;
            float sq = (xn[0] * xn[0] + xn[1] * xn[1]) + (xn[2] * xn[2] + xn[3] * xn[3]); sq += __int_as_float(__builtin_amdgcn_ds_swizzle(__float_as_int(sq), 0x401F));
            if (((col >> 2) & 1) == 0) __hip_atomic_fetch_add(rowss + NPR * 4 + (row - NPR) * 32, sq, __ATOMIC_RELAXED, __HIP_MEMORY_SCOPE_AGENT); } } };
struct SkBf16 { bf16_t* O; bf16_t* O2; const float* scale; const float* rowss; const float* cbw; int ldcb;
    __device__ __forceinline__ void operator()(const f32x4& r, const f32x4&, int row, int col) const {
        bf16_t* base = col >= D ? O2 : O; const int c = col & (D - 1); f32x4 v = r; if (scale) v = v * *(const f32x4*)(scale + c);
        if (rowss) v = v * (1.0f / sqrtf(rowss[NPR * 4 + (row - NPR) * 32] * (1.f / D) + EPS)) + *(const f32x4*)(cbw + (size_t)(8 + row - NPR) * ldcb + col);
        u32x2 w; w.x = cvt_pk_bf16(v[0], v[1]); w.y = cvt_pk_bf16(v[2], v[3]); *(u32x2*)(base + (size_t)row * D + c) = w; } };
struct SkSwiGLU { bf16_t* O; const float* rowss; const float* cbw;
    __device__ __forceinline__ void operator()(const f32x4& g_, const f32x4& u_, int row, int col) const {
        const float rs = 1.0f / sqrtf(rowss[NPR * 4 + (row - NPR) * 32] * (1.f / D) + EPS); const float* cp = cbw + (size_t)(8 + row - NPR) * (2 * FF) + (col >> 7) * 256 + (col & 127);
        const f32x4 g = g_ * rs + *(const f32x4*)cp, u = u_ * rs + *(const f32x4*)(cp + 128);
        u32x2 w; w.x = cvt_pk_bf16(silu_f(g[0]) * u[0], silu_f(g[1]) * u[1]); w.y = cvt_pk_bf16(silu_f(g[2]) * u[2], silu_f(g[3]) * u[3]); *(u32x2*)(O + (size_t)row * FF + col) = w; } };

template <int MODE, int RB, int CH, class EP>
__device__ __forceinline__ void skinny_phase(LAS unsigned char* lds, const Skinny s, const EP& ep) {
    int tid = threadIdx.x; asm volatile("" : "+v"(tid));
    const int lane = tid & 63, wave = __builtin_amdgcn_readfirstlane(tid >> 6), fr = lane & 15, fq = lane >> 4;
    const int kw = s.K >> 3;
    const int bid = s.bx - s.first;
    if (bid < 0) return;
    constexpr int NRG = 8 / RB;
    LAS f32x4* red = (LAS f32x4*)lds;
    for (int t = bid; t < s.ntask * NRG; t += s.navail) {
        const int n0 = (t / NRG) * 16, rg = t % NRG, rbase = NPR + rg * RB * 16;
        const char* Ab = (const char*)s.A; const char* Bb = (const char*)s.Bt;
        const unsigned aoff = (unsigned)((rbase + fr) * s.lda + (s.a_grp ? (n0 >> 8) * 256 : 0) + wave * kw + fq * 8) * 2u, astr = (unsigned)(16 * s.lda) * 2u;
        const int brow = (MODE == 2) ? ((n0 >> 7) * 256 + (n0 & 127)) : n0;
        const unsigned boff = (unsigned)((brow + fr) * s.K + wave * kw + fq * 8) * 2u, bup = (unsigned)(128 * s.K) * 2u;
        f32x4 acc[RB], acc2[RB];
#pragma unroll
        for (int mb = 0; mb < RB; ++mb) { acc[mb] = (f32x4){0.f, 0.f, 0.f, 0.f}; acc2[mb] = (f32x4){0.f, 0.f, 0.f, 0.f}; }
#pragma unroll 1
        for (int k = 0; k < kw; k += 32 * CH) {
            const int ns = (kw - k) >> 5;
            bf16x8 bb[CH], bb2[CH], af[CH][RB];
#pragma unroll
            for (int c = 0; c < CH; ++c) if (c < ns) {
                bb[c] = *(const bf16x8*)(Bb + (boff + (unsigned)(k + 32 * c) * 2u));
                if (MODE == 2) bb2[c] = *(const bf16x8*)(Bb + (boff + bup + (unsigned)(k + 32 * c) * 2u));
#pragma unroll
                for (int mb = 0; mb < RB; ++mb) af[c][mb] = *(const bf16x8*)(Ab + (aoff + (unsigned)mb * astr + (unsigned)(k + 32 * c) * 2u)); }
            __builtin_amdgcn_sched_barrier(0);
#pragma unroll
            for (int c = 0; c < CH; ++c) if (c < ns) {
#pragma unroll
                for (int mb = 0; mb < RB; ++mb) { acc[mb] = __builtin_amdgcn_mfma_f32_16x16x32_bf16(bb[c], af[c][mb], acc[mb], 0, 0, 0);
                    if (MODE == 2) acc2[mb] = __builtin_amdgcn_mfma_f32_16x16x32_bf16(bb2[c], af[c][mb], acc2[mb], 0, 0, 0); } }
            __builtin_amdgcn_sched_barrier(0);
        }
#pragma unroll
        for (int mb = 0; mb < RB; ++mb) { red[(wave * RB + mb) * 64 + lane] = acc[mb]; if (MODE == 2) red[8 * RB * 64 + (wave * RB + mb) * 64 + lane] = acc2[mb]; }
        __syncthreads();
        if (wave < RB) {
            f32x4 r = (f32x4){0.f, 0.f, 0.f, 0.f}, r2 = (f32x4){0.f, 0.f, 0.f, 0.f};
#pragma unroll
            for (int w = 0; w < 8; ++w) { r += red[(w * RB + wave) * 64 + lane]; if (MODE == 2) r2 += red[8 * RB * 64 + (w * RB + wave) * 64 + lane]; }
            ep(r, r2, rbase + wave * 16 + fr, n0 + 4 * fq);
        }
        __syncthreads();
    }
}


struct Args { const float* in[22]; float* out; unsigned char* ws; };
#define AREF const __attribute__((address_space(4))) Args&
__device__ __forceinline__ const __attribute__((address_space(4))) Args* kargs() {
    auto kp = __builtin_amdgcn_kernarg_segment_ptr(); asm volatile("" : "+s"(kp)); return (const __attribute__((address_space(4))) Args*)kp; }
#define XB_TMO      128
#define XB_XCNT(j)  (256  + 64 * (j))
#define XB_XSUB(j)  (1280 + 64 * (j))
#define XB_XGEN(j)  (2304 + 64 * (j))
#define XB_TOP      3328
#define XB_TOPGEN   3392
#define XCD_BAR_WORDS 3456
#define XB_SPIN_CAP (1u << 18)
__device__ __forceinline__ unsigned xb_ld(unsigned* p)              { return __hip_atomic_load(p, __ATOMIC_RELAXED, __HIP_MEMORY_SCOPE_AGENT); }
__device__ __forceinline__ unsigned xb_add(unsigned* p, unsigned v) { return __hip_atomic_fetch_add(p, v, __ATOMIC_RELAXED, __HIP_MEMORY_SCOPE_AGENT); }
__device__ __forceinline__ unsigned xb_xcc_id() { return (unsigned)__builtin_amdgcn_s_getreg((3 << 11) | 20) & 0xFu; }
#define XB_SPIN(cond, bar) do { unsigned _sp = 0; while (cond) { __builtin_amdgcn_s_sleep(8);   \
    if ((++_sp & 255u) == 0u) { if (xb_ld(&(bar)[XB_TMO])) break; if (_sp > XB_SPIN_CAP) { atomicAdd(&(bar)[XB_TMO], 1u); break; } } } } while (0)
struct XcdBarrier { unsigned* bar; unsigned x; volatile LAS unsigned* st; };
__device__ __forceinline__ XcdBarrier xcd_barrier_post(unsigned* bar, volatile LAS unsigned* st) {
    XcdBarrier b; b.bar = bar; b.x = xb_xcc_id(); b.st = st;
    if (threadIdx.x == 0) (void)xb_add(&bar[XB_XCNT(b.x)], 1u);
    return b;
}
__device__ __forceinline__ void xcd_barrier_complete(unsigned* bar, unsigned x, unsigned& nloc, unsigned& nx) {
    const unsigned G = gridDim.x * gridDim.y * gridDim.z;
    unsigned sum, cnt, mine, sp = 0u;
    for (;;) {
        sum = 0u; cnt = 0u; mine = 0u;
#pragma unroll
        for (unsigned j = 0; j < 16; ++j) { const unsigned c = xb_ld(&bar[XB_XCNT(j)]); sum += c; cnt += (c > 0u) ? 1u : 0u; mine = (j == x) ? c : mine; }
        if (sum == G) break;
        __builtin_amdgcn_s_sleep(1);
        if ((++sp & 255u) == 0u) { if (xb_ld(&bar[XB_TMO])) break; if (sp > XB_SPIN_CAP) { atomicAdd(&bar[XB_TMO], 1u); break; } }
    }
    nloc = mine > 0u ? mine : 1u; nx = cnt > 0u ? cnt : 1u;
}
__device__ __forceinline__ void xcd_barrier(const XcdBarrier& b) {
    asm volatile("s_waitcnt vmcnt(0)" ::: "memory");
    __syncthreads();
    if (threadIdx.x == 0) {
        unsigned* bar = (unsigned*)kargs()->ws;
        __builtin_amdgcn_s_waitcnt(0);
        unsigned nloc = b.st[0], nx = b.st[1];
        const unsigned bxcc = xb_xcc_id();
        if (nloc == 0u) { xcd_barrier_complete(bar, bxcc, nloc, nx); b.st[0] = nloc; b.st[1] = nx; }
        const unsigned old = xb_add(&bar[XB_XSUB(bxcc)], 1u);
        const unsigned gen = old / nloc;
        if (old + 1u == (gen + 1u) * nloc) {
            __builtin_amdgcn_fence(__ATOMIC_RELEASE, "agent");
            asm volatile("s_waitcnt vmcnt(0)" ::: "memory");
            const unsigned og = xb_add(&bar[XB_TOP], 1u);
            const unsigned tg = og / nx;
            if (og + 1u == (tg + 1u) * nx) xb_add(&bar[XB_TOPGEN], 1u);
            else XB_SPIN(xb_ld(&bar[XB_TOPGEN]) == tg, bar);
            __builtin_amdgcn_fence(__ATOMIC_ACQUIRE, "agent");
            xb_add(&bar[XB_XGEN(bxcc)], 1u);
            asm volatile("s_waitcnt vmcnt(0)" ::: "memory");
        } else {
            XB_SPIN(xb_ld(&bar[XB_XGEN(bxcc)]) == gen, bar);
            __builtin_amdgcn_fence(__ATOMIC_ACQUIRE, "agent");
            asm volatile("s_waitcnt vmcnt(0)" ::: "memory");
        }
    }
    __syncthreads();
}
enum { I_XP = 0, I_XS, I_SP, I_CP, I_CS, I_WADA, I_BADA, I_NMIX, I_NFFN, I_NFIN, I_PWG, I_PSC, I_PWO, I_GWIN, I_GLG, I_GLB, I_GWS, I_GBS, I_GWO, I_FG, I_FU, I_FD };

#define LDS_WAIT() asm volatile("s_waitcnt lgkmcnt(0)" ::: "memory")

struct TrItem { const float* W; int N; bf16_t* WT; int ldt, k0, n0, drow0; };
__device__ __forceinline__ void tr_load(const TrItem& t, int lane, f32x4 (&v)[8]) {
#pragma unroll
    for (int i = 0; i < 8; ++i) v[i] = *(const f32x4*)(t.W + (size_t)(t.k0 + (lane >> 3) + 8 * i) * t.N + t.n0 + (lane & 7) * 4);
}
__device__ __forceinline__ void tr_store(const TrItem& t, int lane, const f32x4 (&v)[8], LAS float* scr) {
#pragma unroll
    for (int i = 0; i < 8; ++i) { LAS float* s = scr + ((lane >> 3) + 8 * i) * 33 + (lane & 7) * 4; s[0] = v[i][0]; s[1] = v[i][1]; s[2] = v[i][2]; s[3] = v[i][3]; }
    LDS_WAIT(); asm volatile("" ::: "memory");
    const int c = lane & 7;
#pragma unroll
    for (int j = 0; j < 4; ++j) { const int n = (lane >> 3) + 8 * j; const LAS float* s = scr + (8 * c) * 33 + n;
        u32x4 o; o.x = cvt_pk_bf16(s[0 * 33], s[1 * 33]); o.y = cvt_pk_bf16(s[2 * 33], s[3 * 33]); o.z = cvt_pk_bf16(s[4 * 33], s[5 * 33]); o.w = cvt_pk_bf16(s[6 * 33], s[7 * 33]);
        *(u32x4*)(t.WT + (size_t)(t.drow0 + n) * t.ldt + t.k0 + 8 * c) = o; }
    LDS_WAIT(); asm volatile("" ::: "memory");
}

__device__ __forceinline__ float load_row_rstd(const float* xrow, int lane, f32x4 (&v)[4]) {
    const f32x4* xr = (const f32x4*)xrow + lane; float s = 0.f;
#pragma unroll
    for (int j = 0; j < 4; ++j) { v[j] = xr[64 * j]; s += (v[j].x * v[j].x + v[j].y * v[j].y) + (v[j].z * v[j].z + v[j].w * v[j].w); }
    return 1.0f / sqrtf(wave_sum(s) * (1.f / D) + EPS);
}
__device__ __forceinline__ void mod_row(f32x4 (&v)[4], float rstd, const float* wn, const float* sc, const float* sh, int lane) {
#pragma unroll
    for (int j = 0; j < 4; ++j) { const f32x4 w4 = *((const f32x4*)wn + lane + 64 * j), s4 = *((const f32x4*)sc + lane + 64 * j), h4 = *((const f32x4*)sh + lane + 64 * j);
        v[j] = v[j] * rstd * w4 * (1.0f + s4) + h4; }
}

__device__ __forceinline__ void prologue1_phase(AREF a, LAS unsigned char* lds, int gw, int NGW, int wave, int lane) {
    unsigned char* ws = a.ws;
    LAS float* scr = (LAS float*)(lds + wave * 16384);
    constexpr int I_ADA = (D / 64) * (6 * D / 32);
    {
        auto decode = [&](int it) { int r = it; const int l = r / I_ADA; r -= l * I_ADA; const int nblk = 6 * D / 32, kb = r / nblk, nb = r % nblk;
            return TrItem{a.in[I_WADA] + (size_t)l * D * 6 * D, 6 * D, (bf16_t*)(ws + WS_WADA) + (size_t)l * 6 * D * D, D, kb * 64, nb * 32, nb * 32}; };
        int it = gw;
        if (it < 4 * I_ADA) {
            TrItem cur = decode(it); f32x4 v[8]; tr_load(cur, lane, v);
            for (;;) {
                const int itn = it + NGW; const bool has = itn < 4 * I_ADA;
                TrItem nx = cur; f32x4 vn[8];
                if (has) { nx = decode(itn); tr_load(nx, lane, vn); }
                __builtin_amdgcn_sched_barrier(0);
                tr_store(cur, lane, v, scr);
                if (!has) break;
                cur = nx; it = itn;
#pragma unroll
                for (int i = 0; i < 8; ++i) v[i] = vn[i];
            }
        }
    }
    for (int row = gw; row < 256; row += NGW) {
        u32x2* o = (u32x2*)((bf16_t*)(ws + WS_SC) + (size_t)row * D) + lane;
        if (row < NCOND) { const float* cp = row < 8 ? a.in[I_CP] + (size_t)row * D : a.in[I_CS] + (size_t)(row - 8) * D;
#pragma unroll
            for (int j = 0; j < 4; ++j) { const f32x4 c4 = *((const f32x4*)cp + lane + 64 * j); u32x2 w; w.x = cvt_pk_bf16(c4.x / (1.f + __expf(-c4.x)), c4.y / (1.f + __expf(-c4.y))); w.y = cvt_pk_bf16(c4.z / (1.f + __expf(-c4.z)), c4.w / (1.f + __expf(-c4.w))); o[64 * j] = w; } }
        else {
#pragma unroll
            for (int j = 0; j < 4; ++j) o[64 * j] = (u32x2){0u, 0u}; }
    }
    for (int row = gw; row < 2 * 4 * 256; row += NGW) { const int jg = row >> 8; const f32x4 w4 = *((const f32x4*)(a.in[I_PWG] + (size_t)row * 256) + lane), s4 = *((const f32x4*)(a.in[I_PSC] + (size_t)jg * 256) + lane);
        u32x2 o; o.x = cvt_pk_bf16(w4.x * s4.x, w4.y * s4.y); o.y = cvt_pk_bf16(w4.z * s4.z, w4.w * s4.w); ((u32x2*)((bf16_t*)(ws + WS_WPG) + (size_t)row * 256))[lane] = o; }
    for (int i = gw * 64 + lane; i < 6 * RSTR / 4; i += NGW * 64) ((f32x4*)(ws + WS_RSS))[i] = (f32x4){0.f, 0.f, 0.f, 0.f};
    for (int row = gw; row < 2 * 8 * 128; row += NGW) { const int t = row & 127; const float* src = a.in[I_GWS] + (size_t)row * 128; const f32x2 w2 = *((const f32x2*)src + lane);
        const int s0 = 2 * lane; ((unsigned*)((bf16_t*)(ws + WS_WSP) + (size_t)row * 128))[lane] = cvt_pk_bf16(s0 <= t ? w2.x : 0.f, s0 + 1 <= t ? w2.y : 0.f); }
}
constexpr int CTR_WORD = 8192;
__device__ __forceinline__ void prologue2_phase(AREF a, LAS unsigned char* lds, int wave, int lane, int bx, int G) {
    unsigned char* ws = a.ws;
    LAS float* scr = (LAS float*)(lds + wave * 16384);
    constexpr int I_GU = (D / 64) * (FF / 32);
    constexpr int I_DN = (FF / 64) * (D / 32);
    constexpr int I_IN = (D / 64) * (2 * D / 32);
    constexpr int I_SQ = (D / 64) * (D / 32);
    constexpr int NITEMS = 4 * I_SQ + 2 * I_IN + 8 * I_GU + 4 * I_DN;
    const int nA = G < 96 ? G : 96, TOT = (nA + 4 * (G - nA)) * 8;
    const int nslot = bx < nA ? 1 : 4, sbase = bx < nA ? bx * 8 + wave : nA * 8 + ((bx - nA) * 8 + wave) * 4;
#define P2_ITEM(n_) (sbase + (nslot == 4 ? ((n_) >> 2) * TOT + ((n_) & 3) : (n_) * TOT))
    auto decode = [&](int it) {
        int r = it;
        if (r < 4 * I_SQ) { const int lm = r / I_SQ; r -= lm * I_SQ; const int l = lm & 1, po = (lm >> 1) ^ 1; const int nblk = D / 32, kb = r / nblk, nb = r % nblk;
            return TrItem{a.in[po ? I_PWO : I_GWO] + (size_t)l * D * D, D, (bf16_t*)(ws + (po ? WS_WPO : WS_WGO)) + (size_t)l * D * D, D, kb * 64, nb * 32, nb * 32}; }
        r -= 4 * I_SQ;
        if (r < 2 * I_IN) { const int l = r / I_IN; r -= l * I_IN; const int nblk = 2 * D / 32, kb = r / nblk, nb = r % nblk;
            return TrItem{a.in[I_GWIN] + (size_t)l * D * 2 * D, 2 * D, (bf16_t*)(ws + WS_WIN) + (size_t)l * 2 * D * D, D, kb * 64, nb * 32, nb * 32}; }
        r -= 2 * I_IN;
        if (r < 8 * I_GU) { const int lm = r / I_GU; r -= lm * I_GU; const int l = lm >> 1, up = lm & 1; const int nblk = FF / 32, kb = r / nblk, nb = r % nblk, n0 = nb * 32;
            return TrItem{a.in[up ? I_FU : I_FG] + (size_t)l * D * FF, FF, (bf16_t*)(ws + WS_WGU) + (size_t)l * 2 * FF * D, D, kb * 64, n0, (n0 >> 7) * 256 + (n0 & 127) + up * 128}; }
        r -= 8 * I_GU;
        { const int l = r / I_DN; r -= l * I_DN; const int nblk = D / 32, kb = r / nblk, nb = r % nblk;
            return TrItem{a.in[I_FD] + (size_t)l * FF * D, D, (bf16_t*)(ws + WS_WDN) + (size_t)l * D * FF, FF, kb * 64, nb * 32, nb * 32}; } };
    int n = 0, it = P2_ITEM(0);
    if (it < NITEMS) {
        TrItem cur = decode(it); f32x4 v[8]; tr_load(cur, lane, v);
        for (;;) {
            ++n; const int itn = P2_ITEM(n); const bool has = itn < NITEMS;
            TrItem nx = cur; f32x4 vn[8];
            if (has) { nx = decode(itn); tr_load(nx, lane, vn); }
            __builtin_amdgcn_sched_barrier(0);
            tr_store(cur, lane, v, scr);
            if (!has) break;
            cur = nx;
#pragma unroll
            for (int i = 0; i < 8; ++i) v[i] = vn[i];
        }
    }
#undef P2_ITEM
}

__device__ __forceinline__ void norm_phase(const float* x, const float* wn, const float* modl, int shi, int sci, bf16_t* H, int gw, int NGW, int lane_) {
    int lane = lane_; asm volatile("" : "+v"(lane));
    for (int r0 = gw * 8; r0 < NPR; r0 += NGW * 8) {
        const float* mp = modl + (size_t)(r0 >> 11) * MODW;
        f32x4 ca[4], cb[4];
#pragma unroll
        for (int j = 0; j < 4; ++j) { const f32x4 w4 = *((const f32x4*)wn + lane + 64 * j), s4 = *((const f32x4*)(mp + sci * D) + lane + 64 * j); cb[j] = *((const f32x4*)(mp + shi * D) + lane + 64 * j); ca[j] = w4 * (1.0f + s4); }
        {
            f32x4 v[8][4];
#pragma unroll
            for (int q = 0; q < 8; ++q)
#pragma unroll
                for (int j = 0; j < 4; ++j) v[q][j] = *((const f32x4*)(x + (size_t)(r0 + q) * D) + lane + 64 * j);
            __builtin_amdgcn_sched_barrier(0);
            float ss[8];
#pragma unroll
            for (int q = 0; q < 8; ++q) { float t = 0.f;
#pragma unroll
                for (int j = 0; j < 4; ++j) t += (v[q][j].x * v[q][j].x + v[q][j].y * v[q][j].y) + (v[q][j].z * v[q][j].z + v[q][j].w * v[q][j].w);
                ss[q] = t; }
#pragma unroll
            for (int q = 0; q < 8; ++q) ss[q] = wave_sum(ss[q]);
#pragma unroll
            for (int q = 0; q < 8; ++q) { const float rstd = 1.0f / sqrtf(ss[q] * (1.f / D) + EPS); u32x2* o = (u32x2*)(H + (size_t)(r0 + q) * D) + lane;
#pragma unroll
                for (int j = 0; j < 4; ++j) { const f32x4 h = v[q][j] * rstd * ca[j] + cb[j]; u32x2 w; w.x = cvt_pk_bf16(h.x, h.y); w.y = cvt_pk_bf16(h.z, h.w); o[64 * j] = w; } }
        }
    }
    for (int row = NPR + gw; row < MR; row += NGW) {
        f32x4 v[4]; const float rstd = load_row_rstd(x + (size_t)row * D, lane, v);
        const float* mp = modl + (size_t)cond_of(row) * MODW;
        mod_row(v, rstd, wn, mp + sci * D, mp + shi * D, lane);
        u32x2* o = (u32x2*)(H + (size_t)row * D) + lane;
#pragma unroll
        for (int j = 0; j < 4; ++j) { u32x2 w; w.x = cvt_pk_bf16(v[j].x, v[j].y); w.y = cvt_pk_bf16(v[j].z, v[j].w); o[64 * j] = w; }
    }
}
__device__ __forceinline__ void final_phase(const bf16_t* xb, float* y, const float* wn, int gw, int NGW, int lane_) {
    int lane = lane_; asm volatile("" : "+v"(lane));
    f32x4 cw[4];
#pragma unroll
    for (int j = 0; j < 4; ++j) cw[j] = *((const f32x4*)wn + lane + 64 * j);
    const bool has_s = gw < NSM; u32x2 sw[4];
    if (has_s) {
#pragma unroll
        for (int j = 0; j < 4; ++j) sw[j] = *((const u32x2*)(xb + (size_t)(NPR + gw) * D) + lane + 64 * j); }
    for (int r0 = gw * 4; r0 < NPR; r0 += NGW * 4) {
        u32x2 w[4][4];
#pragma unroll
        for (int q = 0; q < 4; ++q)
#pragma unroll
            for (int j = 0; j < 4; ++j) w[q][j] = *((const u32x2*)(xb + (size_t)(r0 + q) * D) + lane + 64 * j);
        __builtin_amdgcn_sched_barrier(0);
        f32x4 v[4][4]; float ss[4];
#pragma unroll
        for (int q = 0; q < 4; ++q) { float t = 0.f;
#pragma unroll
            for (int j = 0; j < 4; ++j) { v[q][j] = (f32x4){bf_lo(w[q][j].x), bf_hi(w[q][j].x), bf_lo(w[q][j].y), bf_hi(w[q][j].y)}; t += (v[q][j].x * v[q][j].x + v[q][j].y * v[q][j].y) + (v[q][j].z * v[q][j].z + v[q][j].w * v[q][j].w); }
            ss[q] = t; }
#pragma unroll
        for (int q = 0; q < 4; ++q) ss[q] = wave_sum(ss[q]);
#pragma unroll
        for (int q = 0; q < 4; ++q) { const float rstd = 1.0f / sqrtf(ss[q] * (1.f / D) + EPS); f32x4* o = (f32x4*)(y + (size_t)(r0 + q) * D) + lane;
#pragma unroll
            for (int j = 0; j < 4; ++j) o[64 * j] = v[q][j] * rstd * cw[j]; }
    }
    if (has_s) { float t = 0.f; f32x4 sv[4];
#pragma unroll
        for (int j = 0; j < 4; ++j) { sv[j] = (f32x4){bf_lo(sw[j].x), bf_hi(sw[j].x), bf_lo(sw[j].y), bf_hi(sw[j].y)}; t += (sv[j].x * sv[j].x + sv[j].y * sv[j].y) + (sv[j].z * sv[j].z + sv[j].w * sv[j].w); }
        const float rstd = 1.0f / sqrtf(wave_sum(t) * (1.f / D) + EPS); f32x4* o = (f32x4*)(y + (size_t)(NPR + gw) * D) + lane;
#pragma unroll
        for (int j = 0; j < 4; ++j) o[64 * j] = sv[j] * rstd * cw[j]; }
}

__device__ __forceinline__ f32x4 ldx4(const char* row, bool is16, int idx) {
    if (is16) { const u32x2 w = *((const u32x2*)row + idx); return (f32x4){bf_lo(w.x), bf_hi(w.x), bf_lo(w.y), bf_hi(w.y)}; }
    return *((const f32x4*)row + idx); }
__device__ __forceinline__ void pool_pre_phase(AREF a, LAS unsigned char* lds, const float* modl, int l, int j, int wave, int lane_, int bx, int G, int nA, int nC) {
    int tid = threadIdx.x; asm volatile("" : "+v"(tid)); const int lane = tid & 63;
    LAS float* hs = (LAS float*)lds;
    const float* wn = a.in[I_NMIX] + (size_t)l * D; bf16_t* H = (bf16_t*)(a.ws + WS_H);
    const bool x16 = l != 0; const size_t rstr = x16 ? (size_t)D * 2 : (size_t)D * 4;
    const char* xpb = x16 ? (const char*)(a.ws + WS_XB) : (const char*)a.in[I_XP]; const char* xsb = x16 ? (const char*)(a.ws + WS_XB) + (size_t)NPR * rstr : (const char*)a.in[I_XS];
#define LDX(base_, row_, jj_) ldx4((base_) + (size_t)(row_) * rstr, x16, lane + 64 * (jj_))
    const int c0 = 2 * tid, w = 2 << (tid >> 7);
    const bool bal = nC > 0 && G == NPR / 64 && nA + nC <= G;
    const int s1 = (bal && bx >= nA && bx - nA < nC) ? bx - nA : -1;
    const int nstr = bal ? ((bx >= nC ? 1 : 0) + (s1 >= 0 ? 1 : 0)) : (NPR / 64 - bx + G - 1) / G;
    for (int qs = 0; qs < nstr; ++qs) {
        const int sidx = bal ? ((qs == 0 && bx >= nC) ? bx : s1) : bx + qs * G;
        const int row_s = sidx * 64, t_s = row_s & (SEQ - 1), cnd = row_s >> 11;
        const float* mp = modl + (size_t)cnd * MODW;
        f32x4 ca[4], cb[4];
#pragma unroll
        for (int jj = 0; jj < 4; ++jj) { const f32x4 w4 = *((const f32x4*)wn + lane + 64 * jj), s4 = *((const f32x4*)(mp + D) + lane + 64 * jj); cb[jj] = *((const f32x4*)mp + lane + 64 * jj); ca[jj] = w4 * (1.0f + s4); }
        f32x4 v[4][4];
#pragma unroll
        for (int q = 0; q < 4; ++q) { const int rr = -15 + wave + 8 * q; const bool ok = rr <= 15 && t_s + rr >= 0;
#pragma unroll
            for (int jj = 0; jj < 4; ++jj) v[q][jj] = ok ? LDX(xpb, row_s + (ok ? rr : 0), jj) : (f32x4){0.f, 0.f, 0.f, 0.f}; }
        __builtin_amdgcn_sched_barrier(0);
        f32x2 S = (f32x2){0.f, 0.f};
#pragma unroll
        for (int c = 0; c < 4; ++c) {
#pragma unroll
            for (int q = 0; q < (c == 0 ? 4 : 2); ++q) { const int rr = (c == 0 ? -15 : 16 * c) + wave + 8 * q;
                if (c != 0 || rr <= 15) { const int t = t_s + rr;
                    if (t >= 0) { float ss = 0.f;
#pragma unroll
                        for (int jj = 0; jj < 4; ++jj) ss += (v[q][jj].x * v[q][jj].x + v[q][jj].y * v[q][jj].y) + (v[q][jj].z * v[q][jj].z + v[q][jj].w * v[q][jj].w);
                        const float rstd = 1.0f / sqrtf(wave_sum(ss) * (1.f / D) + EPS);
#pragma unroll
                        for (int jj = 0; jj < 4; ++jj) v[q][jj] = v[q][jj] * rstd * ca[jj] + cb[jj]; }
                    LAS f32x4* dst = (LAS f32x4*)(hs + ((rr + 32) & 31) * D) + lane;
#pragma unroll
                    for (int jj = 0; jj < 4; ++jj) dst[64 * jj] = v[q][jj];
                    if (rr >= 0 && t >= SEQ - 15) { f32x4* o = (f32x4*)(a.out + O_NPP + ((size_t)(j * 8 + cnd) * 15 + (t - (SEQ - 15))) * D) + lane;
#pragma unroll
                        for (int jj = 0; jj < 4; ++jj) o[64 * jj] = v[q][jj]; }
                } }
            __syncthreads();
            if (c < 3) {
#pragma unroll
                for (int q = 0; q < 2; ++q)
#pragma unroll
                    for (int jj = 0; jj < 4; ++jj) v[q][jj] = LDX(xpb, row_s + 16 * (c + 1) + wave + 8 * q, jj); }
            __builtin_amdgcn_sched_barrier(0);
            for (int r = 16 * c; r < 16 * c + 16; ++r) {
                const f32x2 cur = *(const LAS f32x2*)(hs + ((r + 32) & 31) * D + c0);
                if (r == 0) { for (int q = 0; q < w; ++q) S += *(const LAS f32x2*)(hs + ((32 - q) & 31) * D + c0); }
                else S += cur - *(const LAS f32x2*)(hs + ((r - w + 32) & 31) * D + c0);
                const int tt = t_s + r + 1; const int nn = tt < w ? tt : w;
                const f32x2 p = S * (1.0f / (float)nn) - cur;
                *(unsigned*)(H + (size_t)(row_s + r) * D + c0) = cvt_pk_bf16(p.x, p.y);
            }
            __syncthreads();
        }
    }
    const int nlight = bal ? (nA - nC) + (G - nA - nC) : G;
    const int li = bal ? (bx < nC ? -1 : (bx < nA ? bx - nC : (bx >= nA + nC ? bx - (nA + nC) + (nA - nC) : -1))) : G - 1 - bx;
    for (int b = li; b >= 0 && b < NSM; b += nlight) {
        const int cnd = 8 + b; const float* mp = modl + (size_t)cnd * MODW;
        f32x4 v[2][4];
#pragma unroll
        for (int q = 0; q < 2; ++q) { const int i = wave + 8 * q; const float* src = a.in[I_SP] + ((size_t)(j * NSM + b) * 15 + (i < 15 ? i : 0)) * D;
#pragma unroll
            for (int jj = 0; jj < 4; ++jj) v[q][jj] = i < 15 ? *((const f32x4*)src + lane + 64 * jj) : LDX(xsb, b, jj); }
        __builtin_amdgcn_sched_barrier(0);
#pragma unroll
        for (int q = 0; q < 2; ++q) { const int i = wave + 8 * q;
            if (i == 15) { float ss = 0.f;
#pragma unroll
                for (int jj = 0; jj < 4; ++jj) ss += (v[q][jj].x * v[q][jj].x + v[q][jj].y * v[q][jj].y) + (v[q][jj].z * v[q][jj].z + v[q][jj].w * v[q][jj].w);
                const float rstd = 1.0f / sqrtf(wave_sum(ss) * (1.f / D) + EPS);
#pragma unroll
                for (int jj = 0; jj < 4; ++jj) { const f32x4 w4 = *((const f32x4*)wn + lane + 64 * jj), s4 = *((const f32x4*)(mp + D) + lane + 64 * jj), h4 = *((const f32x4*)mp + lane + 64 * jj); v[q][jj] = v[q][jj] * rstd * (w4 * (1.0f + s4)) + h4; } }
            LAS f32x4* dst = (LAS f32x4*)(hs + i * D) + lane;
#pragma unroll
            for (int jj = 0; jj < 4; ++jj) dst[64 * jj] = v[q][jj];
            if (i >= 1) { f32x4* o = (f32x4*)(a.out + O_NPS + ((size_t)(j * NSM + b) * 15 + (i - 1)) * D) + lane;
#pragma unroll
                for (int jj = 0; jj < 4; ++jj) o[64 * jj] = v[q][jj]; } }
        __syncthreads();
        { f32x2 S = (f32x2){0.f, 0.f};
            for (int q = 0; q < w; ++q) S += *(const LAS f32x2*)(hs + (15 - q) * D + c0);
            const f32x2 cur = *(const LAS f32x2*)(hs + 15 * D + c0);
            const f32x2 p = S * (1.0f / (float)w) - cur;
            *(unsigned*)(H + (size_t)(NPR + b) * D + c0) = cvt_pk_bf16(p.x, p.y); }
        __syncthreads();
    }
}
#undef LDX

__device__ __forceinline__ void spatial_phase(AREF a, LAS unsigned char* lds, int j, int gw, int wave, int lane_, int bx, int G) {
    int tid = threadIdx.x; asm volatile("" : "+v"(tid)); const int lane = tid & 63;
    const bf16_t* U = (const bf16_t*)(a.ws + WS_U); const bf16_t* V = (const bf16_t*)(a.ws + WS_V); bf16_t* B2 = (bf16_t*)(a.ws + WS_B2);
    const float* lng = a.in[I_GLG] + (size_t)j * D; const float* lnb = a.in[I_GLB] + (size_t)j * D;
    const float* bs = a.in[I_GBS] + (size_t)j * 8 * 128;
    const bf16_t* WS = (const bf16_t*)(a.ws + WS_WSP) + (size_t)j * 8 * 128 * 128;
    LAS f32x2* st = (LAS f32x2*)lds;
    LAS bf16_t* vt = (LAS bf16_t*)(lds + 1024);
    LAS bf16_t* wa = (LAS bf16_t*)(lds + 1024 + 128 * 136 * 2);
    constexpr int VLD = 136;
    for (int item = bx; item < 256; item += G) {
        const int ch = item >> 1, hq = item & 1, R0 = ch * 128;
        u32x4 w[16][2], wv[4][4];
        const int d8 = (tid & 15) * 8;
#pragma unroll
        for (int rr = 0; rr < 16; ++rr) { const u32x4* vp = (const u32x4*)(V + (size_t)(R0 + wave * 16 + rr) * D) + lane; w[rr][0] = vp[0]; w[rr][1] = vp[64]; }
#pragma unroll
        for (int gi = 0; gi < 4; ++gi)
#pragma unroll
            for (int ii = 0; ii < 4; ++ii) wv[gi][ii] = *(const u32x4*)(V + (size_t)(R0 + (tid >> 4) + 32 * ii) * D + (hq * 4 + gi) * 128 + d8);
        __builtin_amdgcn_sched_barrier(0);
#pragma unroll
        for (int rr = 0; rr < 16; ++rr) { float sm = 0.f, sq = 0.f;
#pragma unroll
            for (int q = 0; q < 2; ++q)
#pragma unroll
                for (int e = 0; e < 4; ++e) { const float lo = bf_lo(w[rr][q][e]), hi = bf_hi(w[rr][q][e]); sm += lo + hi; sq += lo * lo + hi * hi; }
            sm = wave_sum(sm); sq = wave_sum(sq);
            const float mean = sm * (1.f / D), var = sq * (1.f / D) - mean * mean;
            if (lane == 0) st[wave * 16 + rr] = (f32x2){mean, 1.0f / sqrtf((var > 0.f ? var : 0.f) + EPS)}; }
        __syncthreads();
#pragma unroll
        for (int gi = 0; gi < 4; ++gi) {
            const int g = hq * 4 + gi;
            const bf16_t* wsg = WS + (size_t)g * 128 * 128;
            u32x4 wreg[4];
#pragma unroll
            for (int ii = 0; ii < 4; ++ii) wreg[ii] = *(const u32x4*)(wsg + (size_t)((tid >> 4) + 32 * ii) * 128 + d8);
            { const f32x4 ga = *(const f32x4*)(lng + g * 128 + d8), gb = *(const f32x4*)(lng + g * 128 + d8 + 4), ba = *(const f32x4*)(lnb + g * 128 + d8), bb = *(const f32x4*)(lnb + g * 128 + d8 + 4);
#pragma unroll
                for (int ii = 0; ii < 4; ++ii) { const int s = (tid >> 4) + 32 * ii; const u32x4 w = wv[gi][ii]; const f32x2 ms = st[s];
                    u32x4 o;
                    o.x = cvt_pk_bf16((bf_lo(w.x) - ms.x) * ms.y * ga.x + ba.x, (bf_hi(w.x) - ms.x) * ms.y * ga.y + ba.y);
                    o.y = cvt_pk_bf16((bf_lo(w.y) - ms.x) * ms.y * ga.z + ba.z, (bf_hi(w.y) - ms.x) * ms.y * ga.w + ba.w);
                    o.z = cvt_pk_bf16((bf_lo(w.z) - ms.x) * ms.y * gb.x + bb.x, (bf_hi(w.z) - ms.x) * ms.y * gb.y + bb.y);
                    o.w = cvt_pk_bf16((bf_lo(w.w) - ms.x) * ms.y * gb.z + bb.z, (bf_hi(w.w) - ms.x) * ms.y * gb.w + bb.w);
                    *(LAS u32x4*)(vt + s * VLD + d8) = o; }
#pragma unroll
                for (int ii = 0; ii < 4; ++ii) *(LAS u32x4*)(wa + ((tid >> 4) + 32 * ii) * VLD + d8) = wreg[ii]; }
            __syncthreads();
            {
                const int fr = lane & 15, fq = lane >> 4;
                bf16x8 af[8][4]; u32x2 uw[8]; float bt[8];
#pragma unroll
                for (int mb = 0; mb < 8; ++mb) {
#pragma unroll
                    for (int ks = 0; ks < 4; ++ks) if (ks <= (mb >> 1)) af[mb][ks] = *(const LAS bf16x8*)(wa + (mb * 16 + fr) * VLD + ks * 32 + fq * 8);
                    uw[mb] = *(const u32x2*)(U + (size_t)(R0 + mb * 16 + fr) * D + g * 128 + wave * 16 + 4 * fq); bt[mb] = bs[g * 128 + mb * 16 + fr]; }
                bf16x8 bfr[4];
#pragma unroll
                for (int ks = 0; ks < 4; ++ks)
#pragma unroll
                    for (int e = 0; e < 8; ++e) bfr[ks][e] = (short)vt[(ks * 32 + fq * 8 + e) * VLD + wave * 16 + fr];
                __builtin_amdgcn_sched_barrier(0);
#pragma unroll
                for (int mb = 0; mb < 8; ++mb) {
                    f32x4 acc = (f32x4){0.f, 0.f, 0.f, 0.f};
#pragma unroll
                    for (int ks = 0; ks < 4; ++ks) if (ks <= (mb >> 1)) acc = __builtin_amdgcn_mfma_f32_16x16x32_bf16(bfr[ks], af[mb][ks], acc, 0, 0, 0);
                    const size_t off = (size_t)(R0 + mb * 16 + fr) * D + g * 128 + wave * 16 + 4 * fq;
                    u32x2 o; o.x = cvt_pk_bf16(bf_lo(uw[mb].x) * (acc[0] + bt[mb]), bf_hi(uw[mb].x) * (acc[1] + bt[mb])); o.y = cvt_pk_bf16(bf_lo(uw[mb].y) * (acc[2] + bt[mb]), bf_hi(uw[mb].y) * (acc[3] + bt[mb]));
                    *(u32x2*)(B2 + off) = o;
                }
            }
            __syncthreads();
        }
    }
    if (gw < NSM) {
        const int b = gw, row = NPR + b; const u32x4* vp = (const u32x4*)(V + (size_t)row * D) + lane;
        float vv[16]; float sm = 0.f, sq = 0.f;
#pragma unroll
        for (int q = 0; q < 2; ++q) { const u32x4 w = vp[64 * q];
#pragma unroll
            for (int e = 0; e < 4; ++e) { const float lo = bf_lo(w[e]), hi = bf_hi(w[e]); vv[q * 8 + 2 * e] = lo; vv[q * 8 + 2 * e + 1] = hi; sm += lo + hi; sq += lo * lo + hi * hi; } }
        sm = wave_sum(sm); sq = wave_sum(sq);
        const float mean = sm * (1.f / D), var = sq * (1.f / D) - mean * mean, rstd = 1.0f / sqrtf((var > 0.f ? var : 0.f) + EPS);
#pragma unroll
        for (int q = 0; q < 2; ++q) { const int c0 = lane * 8 + 512 * q, g = c0 >> 7;
            const float w00 = a.in[I_GWS][((size_t)(j * 8 + g) * 128) * 128], b0 = bs[g * 128];
            float vn[8], gt[8]; const u32x4 uw = *(const u32x4*)(U + (size_t)row * D + c0);
#pragma unroll
            for (int e = 0; e < 8; ++e) { vn[e] = (vv[q * 8 + e] - mean) * rstd * lng[c0 + e] + lnb[c0 + e]; const float uu = (e & 1) ? bf_hi(uw[e >> 1]) : bf_lo(uw[e >> 1]); gt[e] = uu * (w00 * vn[e] + b0); }
            float* nv = a.out + O_NV + ((size_t)(j * NSM + b)) * D + c0;
            *(f32x4*)nv = (f32x4){vn[0], vn[1], vn[2], vn[3]}; *(f32x4*)(nv + 4) = (f32x4){vn[4], vn[5], vn[6], vn[7]};
            u32x4 o; o.x = cvt_pk_bf16(gt[0], gt[1]); o.y = cvt_pk_bf16(gt[2], gt[3]); o.z = cvt_pk_bf16(gt[4], gt[5]); o.w = cvt_pk_bf16(gt[6], gt[7]);
            *(u32x4*)(B2 + (size_t)row * D + c0) = o; }
    }
}

#define OPQ int G = gridDim.x, bx = blockIdx.x, wave = wave0; asm volatile("" : "+s"(G), "+s"(bx), "+s"(wave)); const int gw = bx * 8 + wave, NGW = G * 8; (void)gw; (void)NGW;
#define GRID_BAR() xcd_barrier(bar)
#define KA (*kargs())
#define WSB(off) ((bf16_t*)(KA.ws + (off)))
#define MODP ((float*)(KA.ws + WS_MOD))
#define RSS(k) ((float*)(KA.ws + WS_RSS) + (size_t)(k) * RSTR)
#define CBG(k) ((float*)(KA.ws + WS_CBG) + (size_t)(k) * NCOND * 2 * FF)
#define CBI(k) ((float*)(KA.ws + WS_CBI) + (size_t)(k) * NCOND * 2 * D)
template <int l>
__device__ __forceinline__ void layer_body(LAS unsigned char* lds, const XcdBarrier& bar, const int wave0) {
    constexpr int j = l >> 1;
    if constexpr ((l & 1) == 0) {
        { OPQ
            int nA = 0;
            if constexpr (l == 0) {
#pragma unroll 1
                for (int k = 0; k < 6; ++k) {
                    const int start = k < 4 ? 22 * k : 88 + 8 * (k - 4), c = (bx - start + 4 * G) % G, N = k < 4 ? 2 * FF : 2 * D;
                    pg8::Gemm g{WSB(WS_SHB) + (size_t)k * 256 * D, k < 4 ? WSB(WS_WGU) + (size_t)k * 2 * FF * D : WSB(WS_WIN) + (size_t)(k - 4) * 2 * D * D, 256, N, D, D, 0};
                    pg8::StaticOrder S; S.init(256, N, G, c);
                    pg8::EpiCbw E{k < 4 ? CBG(k) : CBI(k - 4), N};
                    pg8::gemm_phase<pg8::EpiCbw>(lds, g, S, E);
                }
#pragma unroll 1
                for (int jj = 0; jj < 2; ++jj) {
                    pg8::Gemm g{WSB(WS_WPO) + (size_t)jj * D * D, WSB(WS_WPG) + (size_t)jj * 4 * 65536, D, D, 256, D, 256};
                    pg8::StaticOrder S; S.init(D, D, G, (bx - 104 - 16 * jj + 4 * G) % G);
                    pg8::EpiBf16 E{WSB(WS_WEF) + (size_t)jj * D * D, WSB(WS_WEF) + (size_t)jj * D * D, nullptr, nullptr, nullptr, 0};
                    pg8::gemm_phase<pg8::EpiBf16>(lds, g, S, E);
                }
                nA = G < 136 ? G : 136;
            }
            pool_pre_phase(KA, lds, MODP + (size_t)l * 6 * D, l, j, wave, 0, bx, G, nA, l == 0 ? 104 : 0);
        }
        GRID_BAR();
        { OPQ
            pg8::Gemm g{WSB(WS_H), WSB(WS_WEF) + (size_t)j * D * D, NPR, D, D, D, 0}; pg8::StaticOrder S; S.init(NPR, D, G, bx);
            pg8::EpiResidT<true> E{l == 0 ? KA.in[I_XP] : nullptr, WSB(WS_XB), WSB(WS_XB), MODP + (size_t)l * 6 * D + 2 * D, WSB(WS_B2), KA.in[I_NFFN] + (size_t)l * D, MODP + (size_t)l * 6 * D + 4 * D, RSS(l)};
            pg8::gemm_phase<pg8::EpiResidT<true>>(lds, g, S, E);
            skinny_phase<0, 2, 4>(lds, Skinny{WSB(WS_H), D, 0, WSB(WS_WEF) + (size_t)j * D * D, D, D / 16, 0, G, bx},
                SkResid{l == 0 ? KA.in[I_XS] : nullptr, WSB(WS_XB), WSB(WS_XB), MODP + (size_t)l * 6 * D + 2 * D, WSB(WS_B2), KA.in[I_NFFN] + (size_t)l * D, MODP + (size_t)l * 6 * D + 4 * D, RSS(l)});
        }
        GRID_BAR();
    } else {
        { OPQ
            pg8::Gemm g{WSB(WS_H), WSB(WS_WIN) + (size_t)j * 2 * D * D, NPR, 2 * D, D, D, 0}; pg8::StaticOrder S; S.init(NPR, 2 * D, G, bx);
            pg8::EpiBf16 E{WSB(WS_U), WSB(WS_V), nullptr, RSS(4 + j), CBI(j), 2 * D};
            pg8::gemm_phase<pg8::EpiBf16>(lds, g, S, E);
            skinny_phase<0, 4, 4>(lds, Skinny{WSB(WS_H), D, 0, WSB(WS_WIN) + (size_t)j * 2 * D * D, D, 2 * D / 16, 0, G, bx}, SkBf16{WSB(WS_U), WSB(WS_V), nullptr, RSS(4 + j), CBI(j), 2 * D});
        }
        GRID_BAR();
        { OPQ spatial_phase(KA, lds, j, gw, wave, 0, bx, G); }
        GRID_BAR();
        { OPQ
            pg8::Gemm g{WSB(WS_B2), WSB(WS_WGO) + (size_t)j * D * D, NPR, D, D, D, 0}; pg8::StaticOrder S; S.init(NPR, D, G, bx);
            pg8::EpiResidT<true> E{nullptr, WSB(WS_XB), WSB(WS_XB), MODP + (size_t)l * 6 * D + 2 * D, WSB(WS_H), KA.in[I_NFFN] + (size_t)l * D, MODP + (size_t)l * 6 * D + 4 * D, RSS(l)};
            pg8::gemm_phase<pg8::EpiResidT<true>>(lds, g, S, E);
            skinny_phase<0, 2, 4>(lds, Skinny{WSB(WS_B2), D, 0, WSB(WS_WGO) + (size_t)j * D * D, D, D / 16, 0, G, bx},
                SkResid{nullptr, WSB(WS_XB), WSB(WS_XB), MODP + (size_t)l * 6 * D + 2 * D, WSB(WS_H), KA.in[I_NFFN] + (size_t)l * D, MODP + (size_t)l * 6 * D + 4 * D, RSS(l)});
        }
        GRID_BAR();
    }
    { OPQ
        pg8::Gemm g{WSB((l & 1) ? WS_H : WS_B2), WSB(WS_WGU) + (size_t)l * 2 * FF * D, NPR, 2 * FF, D, D, 0}; pg8::StaticOrder S; S.init(NPR, 2 * FF, G, bx);
        pg8::stage_swiglu_tables(lds, S, RSS(l), CBG(l));
        pg8::EpiSwiGLU E{WSB(WS_ACT), lds};
        pg8::gemm_phase<pg8::EpiSwiGLU>(lds, g, S, E);
        { const int extra = S.nwg % G; skinny_phase<2, 8, 2>(lds, Skinny{WSB((l & 1) ? WS_H : WS_B2), D, 0, WSB(WS_WGU) + (size_t)l * 2 * FF * D, D, FF / 16, extra, G - extra, bx}, SkSwiGLU{WSB(WS_ACT), RSS(l), CBG(l)}); }
    }
    GRID_BAR();
    { OPQ
        pg8::Gemm g{WSB(WS_ACT), WSB(WS_WDN) + (size_t)l * D * FF, NPR, D, FF, FF, 0}; pg8::StaticOrder S; S.init(NPR, D, G, bx);
        if constexpr ((l & 1) == 0) {
            pg8::EpiResidT<true> E{nullptr, WSB(WS_XB), WSB(WS_XB), MODP + (size_t)l * 6 * D + 5 * D, WSB(WS_H), KA.in[I_NMIX] + (size_t)(l + 1) * D, MODP + (size_t)(l + 1) * 6 * D + 1 * D, RSS(4 + j)};
            pg8::gemm_phase<pg8::EpiResidT<true>>(lds, g, S, E);
            skinny_phase<0, 2, 11>(lds, Skinny{WSB(WS_ACT), FF, 0, WSB(WS_WDN) + (size_t)l * D * FF, FF, D / 16, 0, G, bx},
                SkResid{nullptr, WSB(WS_XB), WSB(WS_XB), MODP + (size_t)l * 6 * D + 5 * D, WSB(WS_H), KA.in[I_NMIX] + (size_t)(l + 1) * D, MODP + (size_t)(l + 1) * 6 * D + 1 * D, RSS(4 + j)});
        } else {
            pg8::EpiResidT<false> E{nullptr, WSB(WS_XB), WSB(WS_XB), MODP + (size_t)l * 6 * D + 5 * D, nullptr, nullptr, nullptr, nullptr};
            pg8::gemm_phase<pg8::EpiResidT<false>>(lds, g, S, E);
            skinny_phase<0, 2, 11>(lds, Skinny{WSB(WS_ACT), FF, 0, WSB(WS_WDN) + (size_t)l * D * FF, FF, D / 16, 0, G, bx},
                SkResid{nullptr, WSB(WS_XB), WSB(WS_XB), MODP + (size_t)l * 6 * D + 5 * D, nullptr, nullptr, nullptr, nullptr});
        }
    }
    GRID_BAR();
}

__global__ void __launch_bounds__(512) mega_fwd(Args a_unused) {
    extern __shared__ __attribute__((aligned(16))) unsigned char lds_raw[];
    LAS unsigned char* lds = (LAS unsigned char*)lds_raw;
    cg::grid_group grid = cg::this_grid();
    const int wave0 = __builtin_amdgcn_readfirstlane((int)threadIdx.x >> 6);
    volatile LAS unsigned* MISC = (volatile LAS unsigned*)(lds + 131072 + 320);
    if (threadIdx.x < 32) MISC[threadIdx.x] = 0u;
    __syncthreads();
    const XcdBarrier bar = xcd_barrier_post((unsigned*)kargs()->ws, MISC + 8);
    if (kargs()->ws == nullptr) grid.sync();

    { OPQ prologue1_phase(KA, lds, gw, NGW, wave, (int)threadIdx.x & 63); }
    GRID_BAR();
    { OPQ
        pg8::Gemm g{WSB(WS_SC), WSB(WS_WADA), 256, MODW, D, D, 0}; pg8::StaticOrder S; S.init(256, MODW, G, bx);
        pg8::EpiAda E{MODP, KA.in[I_BADA], WSB(WS_SHB)};
        pg8::gemm_phase<pg8::EpiAda>(lds, g, S, E);
        prologue2_phase(KA, lds, wave, (int)threadIdx.x & 63, bx, G);
    }
    GRID_BAR();
    layer_body<0>(lds, bar, wave0); layer_body<1>(lds, bar, wave0); layer_body<2>(lds, bar, wave0); layer_body<3>(lds, bar, wave0);
    { OPQ final_phase(WSB(WS_XB), KA.out, KA.in[I_NFIN], gw, NGW, (int)threadIdx.x & 63); }
}

extern "C" void kernel_launch(void* const* d_in, const int* in_sizes, int n_in, void* d_out, int out_size, void* d_ws, size_t ws_size, hipStream_t stream) {
    static int grid = 0;
    if (grid == 0) {
        if (n_in != 22 || ws_size < WS_END) { fprintf(stderr, "kernel_launch: expected 22 inputs and >= %zu bytes of workspace; got %d, %zu\n", (size_t)WS_END, n_in, ws_size); grid = -1; return; }
        int dev = 0, cus = 0, per_cu = 0;
        hipGetDevice(&dev); hipDeviceGetAttribute(&cus, hipDeviceAttributeMultiprocessorCount, dev);
        if (hipFuncSetAttribute((const void*)mega_fwd, hipFuncAttributeMaxDynamicSharedMemorySize, LDS_BYTES) != hipSuccess) { fprintf(stderr, "kernel_launch: hipFuncSetAttribute failed\n"); grid = -1; return; }
        if (hipOccupancyMaxActiveBlocksPerMultiprocessor(&per_cu, (const void*)mega_fwd, 512, LDS_BYTES) != hipSuccess || per_cu < 1) { fprintf(stderr, "kernel_launch: occupancy query says %d\n", per_cu); per_cu = 1; }
        (void)hipGetLastError();
        grid = cus * per_cu;
    }
    if (grid < 0) return;
    Args a{};
    for (int i = 0; i < 22; ++i) a.in[i] = (const float*)d_in[i];
    a.out = (float*)d_out; a.ws = (unsigned char*)d_ws;
    void* args[] = {&a};
    if (hipMemsetAsync(d_ws, 0, 65536, stream) != hipSuccess) { fprintf(stderr, "kernel_launch: memset of barrier words failed\n"); return; }
    hipError_t e = hipLaunchCooperativeKernel((const void*)mega_fwd, dim3(grid), dim3(512), args, LDS_BYTES, stream);
    if (e != hipSuccess) fprintf(stderr, "cooperative launch failed: %s (grid %d)\n", hipGetErrorString(e), grid);
}
```

```cpp
#include <hip/hip_runtime.h>
#include <hip/hip_cooperative_groups.h>
#include <cstdio>
namespace cg = cooperative_groups;

#define LAS __attribute__((address_space(3)))
typedef unsigned short bf16_t;
typedef short bf16x8 __attribute__((ext_vector_type(8)));
typedef float f32x4 __attribute__((ext_vector_type(4)));
typedef float f32x2 __attribute__((ext_vector_type(2)));
typedef unsigned u32x4 __attribute__((ext_vector_type(4)));
typedef unsigned u32x2 __attribute__((ext_vector_type(2)));

constexpr int D = 1024, NPR = 16384, NSM = 128, MR = NPR + NSM  , MP = 16640  , FF = 2816, SEQ = 2048;
constexpr int NCOND = 136, MODW = 4 * 6 * D  ;
constexpr float EPS = 1e-6f;
constexpr size_t O_YP = 0, O_YS = (size_t)NPR * D, O_NPP = O_YS + (size_t)NSM * D, O_NPS = O_NPP + (size_t)2 * 8 * 15 * D, O_NV = O_NPS + (size_t)2 * 128 * 15 * D;
constexpr size_t MiB = 1u << 20;
constexpr size_t WS_WADA = 1 * MiB;
constexpr size_t WS_WGU = WS_WADA + (size_t)MODW * D * 2;
constexpr size_t WS_WDN = WS_WGU + (size_t)4 * 2 * FF * D * 2;
constexpr size_t WS_WIN = WS_WDN + (size_t)4 * D * FF * 2;
constexpr size_t WS_WGO = WS_WIN + (size_t)2 * 2 * D * D * 2;
constexpr size_t WS_WPO = WS_WGO + (size_t)2 * D * D * 2;
constexpr size_t WS_WPG = WS_WPO + (size_t)2 * D * D * 2;
constexpr size_t WS_WSP = WS_WPG + (size_t)2 * 4 * 256 * 256 * 2;
constexpr size_t WS_SC = WS_WSP + (size_t)2 * 8 * 128 * 128 * 2;
constexpr size_t WS_MOD = WS_SC + (size_t)256 * D * 2;
constexpr size_t WS_H = WS_MOD + (size_t)NCOND * MODW * 4;
constexpr size_t WS_B2 = WS_H + (size_t)MP * D * 2;
constexpr size_t WS_ACT = WS_B2 + (size_t)MP * D * 2;
constexpr size_t WS_U = WS_ACT, WS_V = WS_ACT + (size_t)MP * D * 2;
constexpr size_t WS_RSS = WS_ACT + (size_t)MP * FF * 2;
constexpr int RSTR = NPR * 4 + NSM * 32;
constexpr size_t WS_SHB = WS_RSS + (size_t)6 * RSTR * 4;
constexpr size_t WS_CBG = WS_SHB + (size_t)6 * 256 * D * 2;
constexpr size_t WS_CBI = WS_CBG + (size_t)4 * NCOND * 2 * FF * 4;
constexpr size_t WS_WEF = WS_CBI + (size_t)2 * NCOND * 2 * D * 4;
constexpr size_t WS_XB = WS_WEF + (size_t)2 * D * D * 2;
constexpr size_t WS_END = WS_XB + (size_t)MP * D * 2;
constexpr int LDS_BYTES = 147456;

__device__ __forceinline__ unsigned cvt_pk_bf16(float lo, float hi) { unsigned r; asm volatile("v_cvt_pk_bf16_f32 %0, %1, %2" : "=v"(r) : "v"(lo), "v"(hi)); return r; }
__device__ __forceinline__ float bf_lo(unsigned w) { return __uint_as_float(w << 16); }
__device__ __forceinline__ float bf_hi(unsigned w) { return __uint_as_float(w & 0xffff0000u); }
template <int CTRL> __device__ __forceinline__ float dpp_f(float v) { return __int_as_float(__builtin_amdgcn_mov_dpp(__float_as_int(v), CTRL, 0xf, 0xf, true)); }
__device__ __forceinline__ float wave_sum(float v) {
    v += dpp_f<0xB1>(v);
    v += dpp_f<0x4E>(v);
    v += dpp_f<0x141>(v);
    v += dpp_f<0x140>(v);
    const int iv = __float_as_int(v);
    return (__int_as_float(__builtin_amdgcn_readlane(iv, 0)) + __int_as_float(__builtin_amdgcn_readlane(iv, 16))) + (__int_as_float(__builtin_amdgcn_readlane(iv, 32)) + __int_as_float(__builtin_amdgcn_readlane(iv, 48)));
}
__device__ __forceinline__ int cond_of(int row) { int c = row < NPR ? (row >> 11) : 8 + (row - NPR); return c > NCOND - 1 ? NCOND - 1 : c; }
__device__ __forceinline__ float silu_f(float g) { return g * __builtin_amdgcn_rcpf(1.0f + __expf(-g)); }

namespace pg8 {
constexpr int BM = 256, BK = 64, HALF = 128, HTB = HALF * BK * 2, STAGE_BYTES = 8 * HTB, NXCD = 8, WGM = 8;
__device__ __forceinline__ int lds_byte(int r, int c) { const int st = (r >> 4) * 2 + (c >> 5), rr = r & 15, cc = c & 31, ob = rr * 64 + cc * 2; return st * 1024 + (ob ^ (((ob >> 9) & 1) << 5)); }
__device__ __forceinline__ void stage_rc(int b, int& R, int& C) { const int st = b / 1024, sb = b % 1024, swz = sb ^ (((sb >> 9) & 1) << 5); R = (st >> 1) * 16 + swz / 64; C = (st & 1) * 32 + (swz % 64) / 2; }
__device__ __forceinline__ int perm32(int rho) { const int n = rho >> 4, i = rho & 15; return 8 * (i >> 2) + 4 * n + (i & 3); }

struct Unit { int pm, pn, idx; };
struct Gemm { const bf16_t* A; const bf16_t* Bt; int M, N, K, lda, a_pn_step; };

struct StaticOrder {
    int nM, nN, nwg, G, c;
    __device__ void init(int M, int N, int G_, int c_) { nM = M / BM; nN = N / BM; nwg = nM * nN; G = G_; c = c_; }
    __device__ bool next(int i, Unit& u) const {
        const long L = (long)i * G + c; if (L >= nwg) return false;
        int wgid = (int)L; { const int q = nwg / NXCD, r = nwg % NXCD, xcd = wgid % NXCD, off = wgid / NXCD; wgid = (xcd < r ? xcd * (q + 1) : r * (q + 1) + (xcd - r) * q) + off; }
        const int nig = WGM * nN, gid = wgid / nig, fm = gid * WGM, gsz = (nM - fm) < WGM ? (nM - fm) : WGM;
        u.pm = fm + ((wgid % nig) % gsz); u.pn = (wgid % nig) / gsz; u.idx = i; return true;
    }
};


struct EpiAda {
    static constexpr bool PERM = false, AFTER_DRAIN = false;
    float* C; const float* bias; bf16_t* shb;
    __device__ __forceinline__ void operator()(const f32x4 (&acc)[2][2][4][2], const Unit& u, int wr, int wc, int fr, int fq) const {
        const int row0 = u.pm * BM + wr * 64 + fr, col0 = u.pn * BM + wc * 32 + 4 * fq;
        const int tc = u.pn * BM, l = tc / (6 * D), chunk = (tc % (6 * D)) >> 10, cc0 = (tc & (D - 1)) + wc * 32 + 4 * fq;
        const int shidx = chunk == 3 ? l : ((chunk == 0 && (l & 1)) ? 4 + (l >> 1) : -1);
#pragma unroll
        for (int ai = 0; ai < 2; ++ai)
#pragma unroll
            for (int m = 0; m < 4; ++m) { const int row = row0 + ai * HALF + m * 16;
#pragma unroll
                for (int bj = 0; bj < 2; ++bj)
#pragma unroll
                    for (int n = 0; n < 2; ++n) { const f32x4 v = acc[ai][bj][m][n] + *(const f32x4*)(bias + col0 + bj * HALF + n * 16);
                        if (row < NCOND) *(f32x4*)(C + (size_t)row * MODW + col0 + bj * HALF + n * 16) = v;
                        if (shidx >= 0) { u32x2 w; w.x = cvt_pk_bf16(v[0], v[1]); w.y = cvt_pk_bf16(v[2], v[3]); *(u32x2*)(shb + ((size_t)shidx * 256 + row) * D + cc0 + bj * HALF + n * 16) = w; } } }
    }
};
struct EpiCbw {
    static constexpr bool PERM = false, AFTER_DRAIN = false;
    float* C; int ldc;
    __device__ __forceinline__ void operator()(const f32x4 (&acc)[2][2][4][2], const Unit& u, int wr, int wc, int fr, int fq) const {
        const int row0 = u.pm * BM + wr * 64 + fr, col0 = u.pn * BM + wc * 32 + 4 * fq;
#pragma unroll
        for (int ai = 0; ai < 2; ++ai)
#pragma unroll
            for (int m = 0; m < 4; ++m) { const int row = row0 + ai * HALF + m * 16;
                if (row < NCOND) {
#pragma unroll
                    for (int bj = 0; bj < 2; ++bj)
#pragma unroll
                        for (int n = 0; n < 2; ++n) *(f32x4*)(C + (size_t)row * ldc + col0 + bj * HALF + n * 16) = acc[ai][bj][m][n]; } }
    }
};
template <bool XA>
struct EpiResidT {
    static constexpr bool PERM = true, AFTER_DRAIN = XA;
    const float* xin32; const bf16_t* xinb; bf16_t* xb; const float* modg;
    bf16_t* xa; const float* wnn; const float* scn; float* rowss;
    __device__ __forceinline__ void body(const f32x4 (&acc)[2][2][4][2], const Unit& u, int wr, int wc, int fr, int fq, LAS float* P) const {
        const int row0 = u.pm * BM + wr * 64 + fr, col0 = u.pn * BM + wc * 32 + 8 * fq;
        const float* gp = modg + (size_t)(u.pm >> 3) * MODW + col0;
        f32x4 gv[2][2], ca[2][2];
#pragma unroll
        for (int bj = 0; bj < 2; ++bj)
#pragma unroll
            for (int n = 0; n < 2; ++n) { gv[bj][n] = *(const f32x4*)(gp + bj * HALF + 4 * n);
                if (XA) ca[bj][n] = *(const f32x4*)(wnn + col0 + bj * HALF + 4 * n) * (1.0f + *(const f32x4*)(scn + (size_t)(u.pm >> 3) * MODW + col0 + bj * HALF + 4 * n)); }
#pragma unroll
        for (int ai = 0; ai < 2; ++ai)
#pragma unroll
            for (int mp = 0; mp < 2; ++mp) {
                f32x4 xv[2][2][2];
                if (xin32) {
#pragma unroll
                    for (int mm = 0; mm < 2; ++mm) { const float* xp = xin32 + (size_t)(row0 + ai * HALF + (2 * mp + mm) * 16) * D + col0;
#pragma unroll
                        for (int bj = 0; bj < 2; ++bj)
#pragma unroll
                            for (int n = 0; n < 2; ++n) xv[mm][bj][n] = *(const f32x4*)(xp + bj * HALF + 4 * n); }
                } else {
                    u32x4 xw[2][2];
#pragma unroll
                    for (int mm = 0; mm < 2; ++mm)
#pragma unroll
                        for (int bj = 0; bj < 2; ++bj) xw[mm][bj] = *(const u32x4*)(xinb + (size_t)(row0 + ai * HALF + (2 * mp + mm) * 16) * D + col0 + bj * HALF);
#pragma unroll
                    for (int mm = 0; mm < 2; ++mm)
#pragma unroll
                        for (int bj = 0; bj < 2; ++bj) { xv[mm][bj][0] = (f32x4){bf_lo(xw[mm][bj].x), bf_hi(xw[mm][bj].x), bf_lo(xw[mm][bj].y), bf_hi(xw[mm][bj].y)};
                            xv[mm][bj][1] = (f32x4){bf_lo(xw[mm][bj].z), bf_hi(xw[mm][bj].z), bf_lo(xw[mm][bj].w), bf_hi(xw[mm][bj].w)}; }
                }
                __builtin_amdgcn_sched_barrier(0);
#pragma unroll
                for (int mm = 0; mm < 2; ++mm) { const size_t ro = (size_t)(row0 + ai * HALF + (2 * mp + mm) * 16) * D + col0; float sq = 0.f;
#pragma unroll
                    for (int bj = 0; bj < 2; ++bj) {
                        const f32x4 x0 = xv[mm][bj][0] + gv[bj][0] * acc[ai][bj][2 * mp + mm][0], x1 = xv[mm][bj][1] + gv[bj][1] * acc[ai][bj][2 * mp + mm][1];
                        u32x4 w; w.x = cvt_pk_bf16(x0[0], x0[1]); w.y = cvt_pk_bf16(x0[2], x0[3]); w.z = cvt_pk_bf16(x1[0], x1[1]); w.w = cvt_pk_bf16(x1[2], x1[3]);
                        *(u32x4*)(xb + ro + bj * HALF) = w;
                        if (XA) { sq += ((x0[0] * x0[0] + x0[1] * x0[1]) + (x0[2] * x0[2] + x0[3] * x0[3])) + ((x1[0] * x1[0] + x1[1] * x1[1]) + (x1[2] * x1[2] + x1[3] * x1[3]));
                            const f32x4 h0 = x0 * ca[bj][0], h1 = x1 * ca[bj][1];
                            u32x4 hw; hw.x = cvt_pk_bf16(h0[0], h0[1]); hw.y = cvt_pk_bf16(h0[2], h0[3]); hw.z = cvt_pk_bf16(h1[0], h1[1]); hw.w = cvt_pk_bf16(h1[2], h1[3]);
                            *(u32x4*)(xa + ro + bj * HALF) = hw; } }
                    if (XA) { sq += __int_as_float(__builtin_amdgcn_ds_swizzle(__float_as_int(sq), 0x401F));
                        if ((fq & 1) == 0) P[(ai * HALF + wr * 64 + (2 * mp + mm) * 16 + fr) * 8 + wc * 2 + (fq >> 1)] = sq; } }
                __builtin_amdgcn_sched_barrier(0);
            }
    }
    __device__ __forceinline__ void operator()(const f32x4 (&acc)[2][2][4][2], const Unit& u, int wr, int wc, int fr, int fq) const { body(acc, u, wr, wc, fr, fq, nullptr); }
    __device__ __forceinline__ void fused(const f32x4 (&acc)[2][2][4][2], const Unit& u, int wr, int wc, int fr, int fq, LAS unsigned char* lds, int tid) const {
        LAS float* P = (LAS float*)lds;
        body(acc, u, wr, wc, fr, fq, P);
        __syncthreads();
        if (tid < 256) { const f32x4 p0 = *(const LAS f32x4*)(P + tid * 8), p1 = *(const LAS f32x4*)(P + tid * 8 + 4);
            rowss[(size_t)(u.pm * BM + tid) * 4 + u.pn] = ((p0[0] + p0[1]) + (p0[2] + p0[3])) + ((p1[0] + p1[1]) + (p1[2] + p1[3])); }
        __syncthreads();
    }
};
struct EpiBf16 {
    static constexpr bool PERM = true, AFTER_DRAIN = false;
    bf16_t* O; bf16_t* O2; const float* scale; const float* rowss; const float* cbw; int ldcb;
    __device__ __forceinline__ void operator()(const f32x4 (&acc)[2][2][4][2], const Unit& u, int wr, int wc, int fr, int fq) const {
        const int row0 = u.pm * BM + wr * 64 + fr; bf16_t* base = u.pn >= 4 ? O2 : O; const int col0 = (u.pn & 3) * BM + wc * 32 + 8 * fq;
        f32x4 sv[2][2], bv[2][2];
#pragma unroll
        for (int bj = 0; bj < 2; ++bj)
#pragma unroll
            for (int n = 0; n < 2; ++n) { sv[bj][n] = scale ? *(const f32x4*)(scale + col0 + bj * HALF + 4 * n) : (f32x4){1.f, 1.f, 1.f, 1.f};
                bv[bj][n] = rowss ? *(const f32x4*)(cbw + (size_t)(u.pm >> 3) * ldcb + u.pn * BM + wc * 32 + 8 * fq + bj * HALF + 4 * n) : (f32x4){0.f, 0.f, 0.f, 0.f}; }
        float rs[2][4];
#pragma unroll
        for (int ai = 0; ai < 2; ++ai)
#pragma unroll
            for (int m = 0; m < 4; ++m) { rs[ai][m] = 1.0f;
                if (rowss) { const f32x4 p = *(const f32x4*)(rowss + (size_t)(row0 + ai * HALF + m * 16) * 4); rs[ai][m] = __builtin_amdgcn_rsqf(((p[0] + p[1]) + (p[2] + p[3])) * (1.f / D) + EPS); } }
        __builtin_amdgcn_sched_barrier(0);
#pragma unroll
        for (int ai = 0; ai < 2; ++ai)
#pragma unroll
            for (int m = 0; m < 4; ++m) { const int row = row0 + ai * HALF + m * 16; bf16_t* rowp = base + (size_t)row * D + col0;
#pragma unroll
                for (int bj = 0; bj < 2; ++bj) { const f32x4 v0 = acc[ai][bj][m][0] * sv[bj][0] * rs[ai][m] + bv[bj][0], v1 = acc[ai][bj][m][1] * sv[bj][1] * rs[ai][m] + bv[bj][1];
                    u32x4 w; w.x = cvt_pk_bf16(v0[0], v0[1]); w.y = cvt_pk_bf16(v0[2], v0[3]); w.z = cvt_pk_bf16(v1[0], v1[1]); w.w = cvt_pk_bf16(v1[2], v1[3]);
                    *(u32x4*)(rowp + bj * HALF) = w; } }
    }
};
constexpr int TAB_OFF = 131072 + 1024, TAB_STRIDE = 2048, TAB_MAX = 7;
struct EpiSwiGLU {
    static constexpr bool PERM = true, AFTER_DRAIN = false;
    bf16_t* O; LAS unsigned char* lds;
    __device__ __forceinline__ void operator()(const f32x4 (&acc)[2][2][4][2], const Unit& u, int wr, int wc, int fr, int fq) const {
        const int row0 = u.pm * BM + wr * 64 + fr, col0 = u.pn * HALF + wc * 32 + 8 * fq;
        const LAS float* T = (const LAS float*)(lds + TAB_OFF + u.idx * TAB_STRIDE);
        const f32x4 cg0 = *(const LAS f32x4*)(T + 256 + wc * 32 + 8 * fq), cg1 = *(const LAS f32x4*)(T + 256 + wc * 32 + 8 * fq + 4), cu0 = *(const LAS f32x4*)(T + 256 + HALF + wc * 32 + 8 * fq), cu1 = *(const LAS f32x4*)(T + 256 + HALF + wc * 32 + 8 * fq + 4);
#pragma unroll
        for (int ai = 0; ai < 2; ++ai)
#pragma unroll
            for (int m = 0; m < 4; ++m) { const int row = row0 + ai * HALF + m * 16; bf16_t* rowp = O + (size_t)row * FF + col0;
                const float r1 = T[ai * HALF + wr * 64 + m * 16 + fr];
                const f32x4 g0 = acc[ai][0][m][0] * r1 + cg0, g1 = acc[ai][0][m][1] * r1 + cg1, u0 = acc[ai][1][m][0] * r1 + cu0, u1 = acc[ai][1][m][1] * r1 + cu1;
                u32x4 w; w.x = cvt_pk_bf16(silu_f(g0[0]) * u0[0], silu_f(g0[1]) * u0[1]); w.y = cvt_pk_bf16(silu_f(g0[2]) * u0[2], silu_f(g0[3]) * u0[3]);
                w.z = cvt_pk_bf16(silu_f(g1[0]) * u1[0], silu_f(g1[1]) * u1[1]); w.w = cvt_pk_bf16(silu_f(g1[2]) * u1[2], silu_f(g1[3]) * u1[3]);
                *(u32x4*)rowp = w; }
    }
};
__device__ __forceinline__ void stage_swiglu_tables(LAS unsigned char* lds, const StaticOrder& S, const float* rowss, const float* cbw) {
    int tid = threadIdx.x; asm volatile("" : "+v"(tid));
    f32x4 p[TAB_MAX]; float c[TAB_MAX]; bool ok[TAB_MAX];
#pragma unroll
    for (int i = 0; i < TAB_MAX; ++i) { Unit u; ok[i] = S.next(i, u); p[i] = (f32x4){1.f, 1.f, 1.f, 1.f}; c[i] = 0.f;
        if (ok[i]) { if (tid < 256) p[i] = *(const f32x4*)(rowss + (size_t)(u.pm * BM + tid) * 4); else c[i] = cbw[(size_t)(u.pm >> 3) * (2 * FF) + u.pn * BM + (tid - 256)]; } }
    __builtin_amdgcn_sched_barrier(0);
#pragma unroll
    for (int i = 0; i < TAB_MAX; ++i) if (ok[i]) ((LAS float*)(lds + TAB_OFF + i * TAB_STRIDE))[tid] = tid < 256 ? __builtin_amdgcn_rsqf(((p[i][0] + p[i][1]) + (p[i][2] + p[i][3])) * (1.f / D) + EPS) : c[i];
    __syncthreads();
}

template <class Epi>
__device__ __forceinline__ void gemm_phase(LAS unsigned char* lds, const Gemm g, const StaticOrder& S, const Epi& E) {
    int tid_o = threadIdx.x; asm volatile("" : "+v"(tid_o));
    const int tid = tid_o, wid = __builtin_amdgcn_readfirstlane(tid >> 6), lane = tid & 63, wr = wid >> 2, wc = wid & 3, fr = lane & 15, fq = lane >> 4;
    const int K = g.K, nt = K / BK, lda = g.lda;
    unsigned voffA[2], voffB[2];
#pragma unroll
    for (int i = 0; i < 2; ++i) { int R, C; stage_rc(tid * 16 + i * 8192, R, C); const int Rb = Epi::PERM ? ((R & ~31) + perm32(R & 31)) : R;
        voffA[i] = (unsigned)(R * lda + C) * 2u; voffB[i] = (unsigned)(Rb * K + C) * 2u; }
    const size_t kstep = (size_t)(BK * 2);
    const size_t hstepA = (size_t)HALF * lda * 2, hstepB = (size_t)HALF * K * 2;
    const size_t tstepA = 2 * hstepA, tstepB = 2 * hstepB;
    const unsigned ldsw = (unsigned)wid * 1024u;
    const int aoff = lds_byte(wr * 64 + fr, fq * 8), boff = lds_byte(wc * 32 + fr, fq * 8);
#define PG8_SA(b, h) (((b) * 2 + (h)) * HTB)
#define PG8_SB(b, h) ((4 + (b) * 2 + (h)) * HTB)
#define PG8_STAGE(bufoff, gbase, voff) do { _Pragma("unroll") for (int _i = 0; _i < 2; ++_i) \
        __builtin_amdgcn_global_load_lds((const unsigned*)((const char*)(gbase) + (voff)[_i]), (LAS unsigned*)(lds + (bufoff) + ldsw + _i * 8192), 16, 0, 0); } while (0)
#define PG8_LDA(dst, b, h) do { _Pragma("unroll") for (int m = 0; m < 4; ++m) _Pragma("unroll") for (int k = 0; k < 2; ++k) dst[m][k] = *(const LAS bf16x8*)(lds + PG8_SA(b, h) + aoff + m * 2048 + k * 1024); } while (0)
#define PG8_LDB(dst, b, h) do { _Pragma("unroll") for (int n = 0; n < 2; ++n) _Pragma("unroll") for (int k = 0; k < 2; ++k) dst[n][k] = *(const LAS bf16x8*)(lds + PG8_SB(b, h) + boff + n * 2048 + k * 1024); } while (0)
#define PG8_MMA(ai, bj, At, Bt) do { __builtin_amdgcn_s_setprio(1); _Pragma("unroll") for (int m = 0; m < 4; ++m) _Pragma("unroll") for (int n = 0; n < 2; ++n) _Pragma("unroll") for (int k = 0; k < 2; ++k) \
        acc[ai][bj][m][n] = __builtin_amdgcn_mfma_f32_16x16x32_bf16(Bt[n][k], At[m][k], acc[ai][bj][m][n], 0, 0, 0); __builtin_amdgcn_s_setprio(0); } while (0)
#define PG8_WAIT_V(n) asm volatile("s_waitcnt vmcnt(" #n ")" ::: "memory")
#define PG8_WAIT_L(n) asm volatile("s_waitcnt lgkmcnt(" #n ")" ::: "memory")
#define PG8_BAR __builtin_amdgcn_s_barrier()
#define PG8_SCHED __builtin_amdgcn_sched_barrier(0)
    Unit cur, nxt; int ui = 0;
    if (!S.next(0, cur)) return;
    f32x4 acc[2][2][4][2];
#pragma unroll
    for (int a = 0; a < 2; ++a)
#pragma unroll
        for (int b = 0; b < 2; ++b)
#pragma unroll
            for (int m = 0; m < 4; ++m)
#pragma unroll
                for (int n = 0; n < 2; ++n) acc[a][b][m][n] = (f32x4){0.f, 0.f, 0.f, 0.f};
    bf16x8 At[4][2], B0[2][2], B1[2][2];
    const char* cA = (const char*)g.A + (size_t)cur.pm * tstepA + (size_t)cur.pn * g.a_pn_step * 2; const char* cB = (const char*)g.Bt + (size_t)cur.pn * tstepB;
    PG8_STAGE(PG8_SB(0, 0), cB, voffB); PG8_STAGE(PG8_SA(0, 0), cA, voffA); PG8_STAGE(PG8_SB(0, 1), cB + hstepB, voffB); PG8_STAGE(PG8_SA(0, 1), cA + hstepA, voffA);
    if (wr == 1) PG8_BAR;
    PG8_WAIT_V(4); PG8_BAR;
    PG8_STAGE(PG8_SB(1, 0), cB + kstep, voffB); PG8_STAGE(PG8_SA(1, 0), cA + kstep, voffA); PG8_STAGE(PG8_SB(1, 1), cB + hstepB + kstep, voffB);
    PG8_WAIT_V(6); PG8_BAR;
    for (;;) {
        const bool has_next = S.next(ui + 1, nxt);
        const char* nA = has_next ? (const char*)g.A + (size_t)nxt.pm * tstepA + (size_t)nxt.pn * g.a_pn_step * 2 : cA; const char* nB = has_next ? (const char*)g.Bt + (size_t)nxt.pn * tstepB : cB;
        for (int t = 0; t < nt; t += 2) {
            const bool last = (t == nt - 2);
            const char* a1 = cA + (size_t)(t + 1) * kstep;
            const char* a2 = last ? nA : cA + (size_t)(t + 2) * kstep; const char* b2 = last ? nB : cB + (size_t)(t + 2) * kstep;
            const char* a3 = a2 + kstep; const char* b3 = b2 + kstep;
            PG8_LDB(B0, 0, 0); PG8_SCHED; PG8_LDA(At, 0, 0); PG8_STAGE(PG8_SA(1, 1), a1 + hstepA, voffA);
            PG8_WAIT_L(8); PG8_BAR; PG8_WAIT_L(0); PG8_MMA(0, 0, At, B0); PG8_BAR; PG8_SCHED;
            PG8_LDB(B1, 0, 1); PG8_STAGE(PG8_SB(0, 0), b2, voffB);
            PG8_BAR; PG8_WAIT_L(0); PG8_MMA(0, 1, At, B1); PG8_BAR;
            PG8_LDA(At, 0, 1); PG8_STAGE(PG8_SA(0, 0), a2, voffA);
            PG8_BAR; PG8_WAIT_L(0); PG8_MMA(1, 0, At, B0); PG8_BAR; PG8_SCHED;
            PG8_STAGE(PG8_SB(0, 1), b2 + hstepB, voffB);
            PG8_WAIT_V(6); PG8_BAR; PG8_MMA(1, 1, At, B1); PG8_BAR;
            PG8_LDB(B0, 1, 0); PG8_SCHED; PG8_LDA(At, 1, 0); PG8_STAGE(PG8_SA(0, 1), a2 + hstepA, voffA);
            PG8_WAIT_L(8); PG8_BAR; PG8_WAIT_L(0); PG8_MMA(0, 0, At, B0); PG8_BAR; PG8_SCHED;
            PG8_LDB(B1, 1, 1); PG8_STAGE(PG8_SB(1, 0), b3, voffB);
            PG8_BAR; PG8_WAIT_L(0); PG8_MMA(0, 1, At, B1); PG8_BAR;
            PG8_LDA(At, 1, 1); PG8_STAGE(PG8_SA(1, 0), a3, voffA);
            PG8_BAR; PG8_WAIT_L(0); PG8_MMA(1, 0, At, B0); PG8_BAR; PG8_SCHED;
            PG8_STAGE(PG8_SB(1, 1), b3 + hstepB, voffB);
            PG8_WAIT_V(6); PG8_BAR; PG8_MMA(1, 1, At, B1); PG8_BAR;
        }
        if constexpr (!Epi::AFTER_DRAIN) E(acc, cur, wr, wc, fr, fq);
        if (!has_next) break;
#pragma unroll
        for (int a = 0; a < 2; ++a)
#pragma unroll
            for (int b = 0; b < 2; ++b)
#pragma unroll
                for (int m = 0; m < 4; ++m)
#pragma unroll
                    for (int n = 0; n < 2; ++n) acc[a][b][m][n] = (f32x4){0.f, 0.f, 0.f, 0.f};
        cur = nxt; cA = nA; cB = nB; ++ui;
    }
    PG8_WAIT_V(0);
    if (wr == 0) PG8_BAR;
    PG8_BAR;
    if constexpr (Epi::AFTER_DRAIN) E.fused(acc, cur, wr, wc, fr, fq, lds, tid);
#undef PG8_SA
#undef PG8_SB
#undef PG8_STAGE
#undef PG8_LDA
#undef PG8_LDB
#undef PG8_MMA
#undef PG8_WAIT_V
#undef PG8_WAIT_L
#undef PG8_BAR
#undef PG8_SCHED
}
}


struct Skinny { const bf16_t* A; int lda, a_grp; const bf16_t* Bt; int K, ntask, first, navail, bx; };
struct SkResid { const float* xin32; const bf16_t* xinb; bf16_t* xb; const float* modg;
    bf16_t* xa; const float* wnn; const float* scn; float* rowss;
    __device__ __forceinline__ void operator()(const f32x4& r, const f32x4&, int row, int col) const {
        const int cnd = 8 + row - NPR; const f32x4 gv = *(const f32x4*)(modg + (size_t)cnd * MODW + col);
        f32x4 xo;
        if (xin32) xo = *(const f32x4*)(xin32 + (size_t)(row - NPR) * D + col);
        else { const u32x2 w = *(const u32x2*)(xinb + (size_t)row * D + col); xo = (f32x4){bf_lo(w.x), bf_hi(w.x), bf_lo(w.y), bf_hi(w.y)}; }
        const f32x4 xn = xo + gv * r;
        { u32x2 w; w.x = cvt_pk_bf16(xn[0], xn[1]); w.y = cvt_pk_bf16(xn[2], xn[3]); *(u32x2*)(xb + (size_t)row * D + col) = w; }
        if (xa) { const f32x4 hv = xn * (*(const f32x4*)(wnn + col) * (1.0f + *(const f32x4*)(scn + (size_t)cnd * MODW + col)));
            u32x2 w; w.x = cvt_pk_bf16(hv[0], hv[1]); w.y = cvt_pk_bf16(hv[2], hv[3]); *(u32x2*)(xa + (size_t)row * D + col) = w;
            float sq = (xn[0] * xn[0] + xn[1] * xn[1]) + (xn[2] * xn[2] + xn[3] * xn[3]); sq += __int_as_float(__builtin_amdgcn_ds_swizzle(__float_as_int(sq), 0x401F));
            if (((col >> 2) & 1) == 0) __hip_atomic_fetch_add(rowss + NPR * 4 + (row - NPR) * 32, sq, __ATOMIC_RELAXED, __HIP_MEMORY_SCOPE_AGENT); } } };
struct SkBf16 { bf16_t* O; bf16_t* O2; const float* scale; const float* rowss; const float* cbw; int ldcb;
    __device__ __forceinline__ void operator()(const f32x4& r, const f32x4&, int row, int col) const {
        bf16_t* base = col >= D ? O2 : O; const int c = col & (D - 1); f32x4 v = r; if (scale) v = v * *(const f32x4*)(scale + c);
        if (rowss) v = v * (1.0f / sqrtf(rowss[NPR * 4 + (row - NPR) * 32] * (1.f / D) + EPS)) + *(const f32x4*)(cbw + (size_t)(8 + row - NPR) * ldcb + col);
        u32x2 w; w.x = cvt_pk_bf16(v[0], v[1]); w.y = cvt_pk_bf16(v[2], v[3]); *(u32x2*)(base + (size_t)row * D + c) = w; } };
struct SkSwiGLU { bf16_t* O; const float* rowss; const float* cbw;
    __device__ __forceinline__ void operator()(const f32x4& g_, const f32x4& u_, int row, int col) const {
        const float rs = 1.0f / sqrtf(rowss[NPR * 4 + (row - NPR) * 32] * (1.f / D) + EPS); const float* cp = cbw + (size_t)(8 + row - NPR) * (2 * FF) + (col >> 7) * 256 + (col & 127);
        const f32x4 g = g_ * rs + *(const f32x4*)cp, u = u_ * rs + *(const f32x4*)(cp + 128);
        u32x2 w; w.x = cvt_pk_bf16(silu_f(g[0]) * u[0], silu_f(g[1]) * u[1]); w.y = cvt_pk_bf16(silu_f(g[2]) * u[2], silu_f(g[3]) * u[3]); *(u32x2*)(O + (size_t)row * FF + col) = w; } };

template <int MODE, int RB, int CH, class EP>
__device__ __forceinline__ void skinny_phase(LAS unsigned char* lds, const Skinny s, const EP& ep) {
    int tid = threadIdx.x; asm volatile("" : "+v"(tid));
    const int lane = tid & 63, wave = __builtin_amdgcn_readfirstlane(tid >> 6), fr = lane & 15, fq = lane >> 4;
    const int kw = s.K >> 3;
    const int bid = s.bx - s.first;
    if (bid < 0) return;
    constexpr int NRG = 8 / RB;
    LAS f32x4* red = (LAS f32x4*)lds;
    for (int t = bid; t < s.ntask * NRG; t += s.navail) {
        const int n0 = (t / NRG) * 16, rg = t % NRG, rbase = NPR + rg * RB * 16;
        const char* Ab = (const char*)s.A; const char* Bb = (const char*)s.Bt;
        const unsigned aoff = (unsigned)((rbase + fr) * s.lda + (s.a_grp ? (n0 >> 8) * 256 : 0) + wave * kw + fq * 8) * 2u, astr = (unsigned)(16 * s.lda) * 2u;
        const int brow = (MODE == 2) ? ((n0 >> 7) * 256 + (n0 & 127)) : n0;
        const unsigned boff = (unsigned)((brow + fr) * s.K + wave * kw + fq * 8) * 2u, bup = (unsigned)(128 * s.K) * 2u;
        f32x4 acc[RB], acc2[RB];
#pragma unroll
        for (int mb = 0; mb < RB; ++mb) { acc[mb] = (f32x4){0.f, 0.f, 0.f, 0.f}; acc2[mb] = (f32x4){0.f, 0.f, 0.f, 0.f}; }
#pragma unroll 1
        for (int k = 0; k < kw; k += 32 * CH) {
            const int ns = (kw - k) >> 5;
            bf16x8 bb[CH], bb2[CH], af[CH][RB];
#pragma unroll
            for (int c = 0; c < CH; ++c) if (c < ns) {
                bb[c] = *(const bf16x8*)(Bb + (boff + (unsigned)(k + 32 * c) * 2u));
                if (MODE == 2) bb2[c] = *(const bf16x8*)(Bb + (boff + bup + (unsigned)(k + 32 * c) * 2u));
#pragma unroll
                for (int mb = 0; mb < RB; ++mb) af[c][mb] = *(const bf16x8*)(Ab + (aoff + (unsigned)mb * astr + (unsigned)(k + 32 * c) * 2u)); }
            __builtin_amdgcn_sched_barrier(0);
#pragma unroll
            for (int c = 0; c < CH; ++c) if (c < ns) {
#pragma unroll
                for (int mb = 0; mb < RB; ++mb) { acc[mb] = __builtin_amdgcn_mfma_f32_16x16x32_bf16(bb[c], af[c][mb], acc[mb], 0, 0, 0);
                    if (MODE == 2) acc2[mb] = __builtin_amdgcn_mfma_f32_16x16x32_bf16(bb2[c], af[c][mb], acc2[mb], 0, 0, 0); } }
            __builtin_amdgcn_sched_barrier(0);
        }
#pragma unroll
        for (int mb = 0; mb < RB; ++mb) { red[(wave * RB + mb) * 64 + lane] = acc[mb]; if (MODE == 2) red[8 * RB * 64 + (wave * RB + mb) * 64 + lane] = acc2[mb]; }
        __syncthreads();
        if (wave < RB) {
            f32x4 r = (f32x4){0.f, 0.f, 0.f, 0.f}, r2 = (f32x4){0.f, 0.f, 0.f, 0.f};
#pragma unroll
            for (int w = 0; w < 8; ++w) { r += red[(w * RB + wave) * 64 + lane]; if (MODE == 2) r2 += red[8 * RB * 64 + (w * RB + wave) * 64 + lane]; }
            ep(r, r2, rbase + wave * 16 + fr, n0 + 4 * fq);
        }
        __syncthreads();
    }
}


struct Args { const float* in[22]; float* out; unsigned char* ws; };
#define AREF const __attribute__((address_space(4))) Args&
__device__ __forceinline__ const __attribute__((address_space(4))) Args* kargs() {
    auto kp = __builtin_amdgcn_kernarg_segment_ptr(); asm volatile("" : "+s"(kp)); return (const __attribute__((address_space(4))) Args*)kp; }
#define XB_TMO      128
#define XB_XCNT(j)  (256  + 64 * (j))
#define XB_XSUB(j)  (1280 + 64 * (j))
#define XB_XGEN(j)  (2304 + 64 * (j))
#define XB_TOP      3328
#define XB_TOPGEN   3392
#define XCD_BAR_WORDS 3456
#define XB_SPIN_CAP (1u << 18)
__device__ __forceinline__ unsigned xb_ld(unsigned* p)              { return __hip_atomic_load(p, __ATOMIC_RELAXED, __HIP_MEMORY_SCOPE_AGENT); }
__device__ __forceinline__ unsigned xb_add(unsigned* p, unsigned v) { return __hip_atomic_fetch_add(p, v, __ATOMIC_RELAXED, __HIP_MEMORY_SCOPE_AGENT); }
__device__ __forceinline__ unsigned xb_xcc_id() { return (unsigned)__builtin_amdgcn_s_getreg((3 << 11) | 20) & 0xFu; }
#define XB_SPIN(cond, bar) do { unsigned _sp = 0; while (cond) { __builtin_amdgcn_s_sleep(1); \
    if ((++_sp & 255u) == 0u) { if (xb_ld(&(bar)[XB_TMO])) break; if (_sp > XB_SPIN_CAP) { atomicAdd(&(bar)[XB_TMO], 1u); break; } } } } while (0)
struct XcdBarrier { unsigned* bar; unsigned x; volatile LAS unsigned* st; };
__device__ __forceinline__ XcdBarrier xcd_barrier_post(unsigned* bar, volatile LAS unsigned* st) {
    XcdBarrier b; b.bar = bar; b.x = xb_xcc_id(); b.st = st;
    if (threadIdx.x == 0) (void)xb_add(&bar[XB_XCNT(b.x)], 1u);
    return b;
}
__device__ __forceinline__ void xcd_barrier_complete(unsigned* bar, unsigned x, unsigned& nloc, unsigned& nx) {
    const unsigned G = gridDim.x * gridDim.y * gridDim.z;
    unsigned sum, cnt, mine, sp = 0u;
    for (;;) {
        sum = 0u; cnt = 0u; mine = 0u;
#pragma unroll
        for (unsigned j = 0; j < 16; ++j) { const unsigned c = xb_ld(&bar[XB_XCNT(j)]); sum += c; cnt += (c > 0u) ? 1u : 0u; mine = (j == x) ? c : mine; }
        if (sum == G) break;
        __builtin_amdgcn_s_sleep(1);
        if ((++sp & 255u) == 0u) { if (xb_ld(&bar[XB_TMO])) break; if (sp > XB_SPIN_CAP) { atomicAdd(&bar[XB_TMO], 1u); break; } }
    }
    nloc = mine > 0u ? mine : 1u; nx = cnt > 0u ? cnt : 1u;
}
__device__ __forceinline__ void xcd_barrier(const XcdBarrier& b) {
    asm volatile("s_waitcnt vmcnt(0)" ::: "memory");
    __syncthreads();
    if (threadIdx.x == 0) {
        unsigned* bar = (unsigned*)kargs()->ws;
        __builtin_amdgcn_s_waitcnt(0);
        unsigned nloc = b.st[0], nx = b.st[1];
        const unsigned bxcc = xb_xcc_id();
        if (nloc == 0u) { xcd_barrier_complete(bar, bxcc, nloc, nx); b.st[0] = nloc; b.st[1] = nx; }
        const unsigned old = xb_add(&bar[XB_XSUB(bxcc)], 1u);
        const unsigned gen = old / nloc;
        if (old + 1u == (gen + 1u) * nloc) {
            __builtin_amdgcn_fence(__ATOMIC_RELEASE, "agent");
            asm volatile("s_waitcnt vmcnt(0)" ::: "memory");
            const unsigned og = xb_add(&bar[XB_TOP], 1u);
            const unsigned tg = og / nx;
            if (og + 1u == (tg + 1u) * nx) xb_add(&bar[XB_TOPGEN], 1u);
            else XB_SPIN(xb_ld(&bar[XB_TOPGEN]) == tg, bar);
            __builtin_amdgcn_fence(__ATOMIC_ACQUIRE, "agent");
            xb_add(&bar[XB_XGEN(bxcc)], 1u);
            asm volatile("s_waitcnt vmcnt(0)" ::: "memory");
        } else {
            XB_SPIN(xb_ld(&bar[XB_XGEN(bxcc)]) == gen, bar);
            __builtin_amdgcn_fence(__ATOMIC_ACQUIRE, "agent");
            asm volatile("s_waitcnt vmcnt(0)" ::: "memory");
        }
    }
    __syncthreads();
}
enum { I_XP = 0, I_XS, I_SP, I_CP, I_CS, I_WADA, I_BADA, I_NMIX, I_NFFN, I_NFIN, I_PWG, I_PSC, I_PWO, I_GWIN, I_GLG, I_GLB, I_GWS, I_GBS, I_GWO, I_FG, I_FU, I_FD };

#define LDS_WAIT() asm volatile("s_waitcnt lgkmcnt(0)" ::: "memory")

struct TrItem { const float* W; int N; bf16_t* WT; int ldt, k0, n0, drow0; };
__device__ __forceinline__ void tr_load(const TrItem& t, int lane, f32x4 (&v)[8]) {
#pragma unroll
    for (int i = 0; i < 8; ++i) v[i] = __builtin_nontemporal_load((const f32x4*)(t.W + (size_t)(t.k0 + (lane >> 3) + 8 * i) * t.N + t.n0 + (lane & 7) * 4));
}
__device__ __forceinline__ void tr_store(const TrItem& t, int lane, const f32x4 (&v)[8], LAS float* scr) {
#pragma unroll
    for (int i = 0; i < 8; ++i) { LAS float* s = scr + ((lane >> 3) + 8 * i) * 33 + (lane & 7) * 4; s[0] = v[i][0]; s[1] = v[i][1]; s[2] = v[i][2]; s[3] = v[i][3]; }
    LDS_WAIT(); asm volatile("" ::: "memory");
    const int c = lane & 7;
#pragma unroll
    for (int j = 0; j < 4; ++j) { const int n = (lane >> 3) + 8 * j; const LAS float* s = scr + (8 * c) * 33 + n;
        u32x4 o; o.x = cvt_pk_bf16(s[0 * 33], s[1 * 33]); o.y = cvt_pk_bf16(s[2 * 33], s[3 * 33]); o.z = cvt_pk_bf16(s[4 * 33], s[5 * 33]); o.w = cvt_pk_bf16(s[6 * 33], s[7 * 33]);
        *(u32x4*)(t.WT + (size_t)(t.drow0 + n) * t.ldt + t.k0 + 8 * c) = o; }
    LDS_WAIT(); asm volatile("" ::: "memory");
}

__device__ __forceinline__ float load_row_rstd(const float* xrow, int lane, f32x4 (&v)[4]) {
    const f32x4* xr = (const f32x4*)xrow + lane; float s = 0.f;
#pragma unroll
    for (int j = 0; j < 4; ++j) { v[j] = xr[64 * j]; s += (v[j].x * v[j].x + v[j].y * v[j].y) + (v[j].z * v[j].z + v[j].w * v[j].w); }
    return 1.0f / sqrtf(wave_sum(s) * (1.f / D) + EPS);
}
__device__ __forceinline__ void mod_row(f32x4 (&v)[4], float rstd, const float* wn, const float* sc, const float* sh, int lane) {
#pragma unroll
    for (int j = 0; j < 4; ++j) { const f32x4 w4 = *((const f32x4*)wn + lane + 64 * j), s4 = *((const f32x4*)sc + lane + 64 * j), h4 = *((const f32x4*)sh + lane + 64 * j);
        v[j] = v[j] * rstd * w4 * (1.0f + s4) + h4; }
}

__device__ __forceinline__ void prologue1_phase(AREF a, LAS unsigned char* lds, int gw, int NGW, int wave, int lane) {
    unsigned char* ws = a.ws;
    LAS float* scr = (LAS float*)(lds + wave * 16384);
    constexpr int I_ADA = (D / 64) * (6 * D / 32);
    {
        auto decode = [&](int it) { int r = it; const int l = r / I_ADA; r -= l * I_ADA; const int nblk = 6 * D / 32, kb = r / nblk, nb = r % nblk;
            return TrItem{a.in[I_WADA] + (size_t)l * D * 6 * D, 6 * D, (bf16_t*)(ws + WS_WADA) + (size_t)l * 6 * D * D, D, kb * 64, nb * 32, nb * 32}; };
        int it = gw;
        if (it < 4 * I_ADA) {
            TrItem cur = decode(it); f32x4 v[8]; tr_load(cur, lane, v);
            for (;;) {
                const int itn = it + NGW; const bool has = itn < 4 * I_ADA;
                TrItem nx = cur; f32x4 vn[8];
                if (has) { nx = decode(itn); tr_load(nx, lane, vn); }
                __builtin_amdgcn_sched_barrier(0);
                tr_store(cur, lane, v, scr);
                if (!has) break;
                cur = nx; it = itn;
#pragma unroll
                for (int i = 0; i < 8; ++i) v[i] = vn[i];
            }
        }
    }
    for (int row = gw; row < 256; row += NGW) {
        u32x2* o = (u32x2*)((bf16_t*)(ws + WS_SC) + (size_t)row * D) + lane;
        if (row < NCOND) { const float* cp = row < 8 ? a.in[I_CP] + (size_t)row * D : a.in[I_CS] + (size_t)(row - 8) * D;
#pragma unroll
            for (int j = 0; j < 4; ++j) { const f32x4 c4 = *((const f32x4*)cp + lane + 64 * j); u32x2 w; w.x = cvt_pk_bf16(c4.x / (1.f + __expf(-c4.x)), c4.y / (1.f + __expf(-c4.y))); w.y = cvt_pk_bf16(c4.z / (1.f + __expf(-c4.z)), c4.w / (1.f + __expf(-c4.w))); o[64 * j] = w; } }
        else {
#pragma unroll
            for (int j = 0; j < 4; ++j) o[64 * j] = (u32x2){0u, 0u}; }
    }
    for (int row = gw; row < 2 * 4 * 256; row += NGW) { const int jg = row >> 8; const f32x4 w4 = *((const f32x4*)(a.in[I_PWG] + (size_t)row * 256) + lane), s4 = *((const f32x4*)(a.in[I_PSC] + (size_t)jg * 256) + lane);
        u32x2 o; o.x = cvt_pk_bf16(w4.x * s4.x, w4.y * s4.y); o.y = cvt_pk_bf16(w4.z * s4.z, w4.w * s4.w); ((u32x2*)((bf16_t*)(ws + WS_WPG) + (size_t)row * 256))[lane] = o; }
    for (int i = gw * 64 + lane; i < 6 * RSTR / 4; i += NGW * 64) ((f32x4*)(ws + WS_RSS))[i] = (f32x4){0.f, 0.f, 0.f, 0.f};
    for (int row = gw; row < 2 * 8 * 128; row += NGW) { const int t = row & 127; const float* src = a.in[I_GWS] + (size_t)row * 128; const f32x2 w2 = *((const f32x2*)src + lane);
        const int s0 = 2 * lane; ((unsigned*)((bf16_t*)(ws + WS_WSP) + (size_t)row * 128))[lane] = cvt_pk_bf16(s0 <= t ? w2.x : 0.f, s0 + 1 <= t ? w2.y : 0.f); }
}
constexpr int CTR_WORD = 8192;
__device__ __forceinline__ void prologue2_phase(AREF a, LAS unsigned char* lds, int wave, int lane, int bx, int G) {
    unsigned char* ws = a.ws;
    LAS float* scr = (LAS float*)(lds + wave * 16384);
    constexpr int I_GU = (D / 64) * (FF / 32);
    constexpr int I_DN = (FF / 64) * (D / 32);
    constexpr int I_IN = (D / 64) * (2 * D / 32);
    constexpr int I_SQ = (D / 64) * (D / 32);
    constexpr int NITEMS = 4 * I_SQ + 2 * I_IN + 8 * I_GU + 4 * I_DN;
    const int nA = G < 96 ? G : 96, TOT = (nA + 4 * (G - nA)) * 8;
    const int nslot = bx < nA ? 1 : 4, sbase = bx < nA ? bx * 8 + wave : nA * 8 + ((bx - nA) * 8 + wave) * 4;
#define P2_ITEM(n_) (sbase + (nslot == 4 ? ((n_) >> 2) * TOT + ((n_) & 3) : (n_) * TOT))
    auto decode = [&](int it) {
        int r = it;
        if (r < 4 * I_SQ) { const int lm = r / I_SQ; r -= lm * I_SQ; const int l = lm & 1, po = (lm >> 1) ^ 1; const int nblk = D / 32, kb = r / nblk, nb = r % nblk;
            return TrItem{a.in[po ? I_PWO : I_GWO] + (size_t)l * D * D, D, (bf16_t*)(ws + (po ? WS_WPO : WS_WGO)) + (size_t)l * D * D, D, kb * 64, nb * 32, nb * 32}; }
        r -= 4 * I_SQ;
        if (r < 2 * I_IN) { const int l = r / I_IN; r -= l * I_IN; const int nblk = 2 * D / 32, kb = r / nblk, nb = r % nblk;
            return TrItem{a.in[I_GWIN] + (size_t)l * D * 2 * D, 2 * D, (bf16_t*)(ws + WS_WIN) + (size_t)l * 2 * D * D, D, kb * 64, nb * 32, nb * 32}; }
        r -= 2 * I_IN;
        if (r < 8 * I_GU) { const int lm = r / I_GU; r -= lm * I_GU; const int l = lm >> 1, up = lm & 1; const int nblk = FF / 32, kb = r / nblk, nb = r % nblk, n0 = nb * 32;
            return TrItem{a.in[up ? I_FU : I_FG] + (size_t)l * D * FF, FF, (bf16_t*)(ws + WS_WGU) + (size_t)l * 2 * FF * D, D, kb * 64, n0, (n0 >> 7) * 256 + (n0 & 127) + up * 128}; }
        r -= 8 * I_GU;
        { const int l = r / I_DN; r -= l * I_DN; const int nblk = D / 32, kb = r / nblk, nb = r % nblk;
            return TrItem{a.in[I_FD] + (size_t)l * FF * D, D, (bf16_t*)(ws + WS_WDN) + (size_t)l * D * FF, FF, kb * 64, nb * 32, nb * 32}; } };
    int n = 0, it = P2_ITEM(0);
    if (it < NITEMS) {
        TrItem cur = decode(it); f32x4 v[8]; tr_load(cur, lane, v);
        for (;;) {
            ++n; const int itn = P2_ITEM(n); const bool has = itn < NITEMS;
            TrItem nx = cur; f32x4 vn[8];
            if (has) { nx = decode(itn); tr_load(nx, lane, vn); }
            __builtin_amdgcn_sched_barrier(0);
            tr_store(cur, lane, v, scr);
            if (!has) break;
            cur = nx;
#pragma unroll
            for (int i = 0; i < 8; ++i) v[i] = vn[i];
        }
    }
#undef P2_ITEM
}

__device__ __forceinline__ void norm_phase(const float* x, const float* wn, const float* modl, int shi, int sci, bf16_t* H, int gw, int NGW, int lane_) {
    int lane = lane_; asm volatile("" : "+v"(lane));
    for (int r0 = gw * 8; r0 < NPR; r0 += NGW * 8) {
        const float* mp = modl + (size_t)(r0 >> 11) * MODW;
        f32x4 ca[4], cb[4];
#pragma unroll
        for (int j = 0; j < 4; ++j) { const f32x4 w4 = *((const f32x4*)wn + lane + 64 * j), s4 = *((const f32x4*)(mp + sci * D) + lane + 64 * j); cb[j] = *((const f32x4*)(mp + shi * D) + lane + 64 * j); ca[j] = w4 * (1.0f + s4); }
        {
            f32x4 v[8][4];
#pragma unroll
            for (int q = 0; q < 8; ++q)
#pragma unroll
                for (int j = 0; j < 4; ++j) v[q][j] = *((const f32x4*)(x + (size_t)(r0 + q) * D) + lane + 64 * j);
            __builtin_amdgcn_sched_barrier(0);
            float ss[8];
#pragma unroll
            for (int q = 0; q < 8; ++q) { float t = 0.f;
#pragma unroll
                for (int j = 0; j < 4; ++j) t += (v[q][j].x * v[q][j].x + v[q][j].y * v[q][j].y) + (v[q][j].z * v[q][j].z + v[q][j].w * v[q][j].w);
                ss[q] = t; }
#pragma unroll
            for (int q = 0; q < 8; ++q) ss[q] = wave_sum(ss[q]);
#pragma unroll
            for (int q = 0; q < 8; ++q) { const float rstd = 1.0f / sqrtf(ss[q] * (1.f / D) + EPS); u32x2* o = (u32x2*)(H + (size_t)(r0 + q) * D) + lane;
#pragma unroll
                for (int j = 0; j < 4; ++j) { const f32x4 h = v[q][j] * rstd * ca[j] + cb[j]; u32x2 w; w.x = cvt_pk_bf16(h.x, h.y); w.y = cvt_pk_bf16(h.z, h.w); o[64 * j] = w; } }
        }
    }
    for (int row = NPR + gw; row < MR; row += NGW) {
        f32x4 v[4]; const float rstd = load_row_rstd(x + (size_t)row * D, lane, v);
        const float* mp = modl + (size_t)cond_of(row) * MODW;
        mod_row(v, rstd, wn, mp + sci * D, mp + shi * D, lane);
        u32x2* o = (u32x2*)(H + (size_t)row * D) + lane;
#pragma unroll
        for (int j = 0; j < 4; ++j) { u32x2 w; w.x = cvt_pk_bf16(v[j].x, v[j].y); w.y = cvt_pk_bf16(v[j].z, v[j].w); o[64 * j] = w; }
    }
}
__device__ __forceinline__ void final_phase(const bf16_t* xb, float* y, const float* wn, int gw, int NGW, int lane_) {
    int lane = lane_; asm volatile("" : "+v"(lane));
    f32x4 cw[4];
#pragma unroll
    for (int j = 0; j < 4; ++j) cw[j] = *((const f32x4*)wn + lane + 64 * j);
    const bool has_s = gw < NSM; u32x2 sw[4];
    if (has_s) {
#pragma unroll
        for (int j = 0; j < 4; ++j) sw[j] = *((const u32x2*)(xb + (size_t)(NPR + gw) * D) + lane + 64 * j); }
    for (int r0 = gw * 4; r0 < NPR; r0 += NGW * 4) {
        u32x2 w[4][4];
#pragma unroll
        for (int q = 0; q < 4; ++q)
#pragma unroll
            for (int j = 0; j < 4; ++j) w[q][j] = *((const u32x2*)(xb + (size_t)(r0 + q) * D) + lane + 64 * j);
        __builtin_amdgcn_sched_barrier(0);
        f32x4 v[4][4]; float ss[4];
#pragma unroll
        for (int q = 0; q < 4; ++q) { float t = 0.f;
#pragma unroll
            for (int j = 0; j < 4; ++j) { v[q][j] = (f32x4){bf_lo(w[q][j].x), bf_hi(w[q][j].x), bf_lo(w[q][j].y), bf_hi(w[q][j].y)}; t += (v[q][j].x * v[q][j].x + v[q][j].y * v[q][j].y) + (v[q][j].z * v[q][j].z + v[q][j].w * v[q][j].w); }
            ss[q] = t; }
#pragma unroll
        for (int q = 0; q < 4; ++q) ss[q] = wave_sum(ss[q]);
#pragma unroll
        for (int q = 0; q < 4; ++q) { const float rstd = 1.0f / sqrtf(ss[q] * (1.f / D) + EPS); f32x4* o = (f32x4*)(y + (size_t)(r0 + q) * D) + lane;
#pragma unroll
            for (int j = 0; j < 4; ++j) o[64 * j] = v[q][j] * rstd * cw[j]; }
    }
    if (has_s) { float t = 0.f; f32x4 sv[4];
#pragma unroll
        for (int j = 0; j < 4; ++j) { sv[j] = (f32x4){bf_lo(sw[j].x), bf_hi(sw[j].x), bf_lo(sw[j].y), bf_hi(sw[j].y)}; t += (sv[j].x * sv[j].x + sv[j].y * sv[j].y) + (sv[j].z * sv[j].z + sv[j].w * sv[j].w); }
        const float rstd = 1.0f / sqrtf(wave_sum(t) * (1.f / D) + EPS); f32x4* o = (f32x4*)(y + (size_t)(NPR + gw) * D) + lane;
#pragma unroll
        for (int j = 0; j < 4; ++j) o[64 * j] = sv[j] * rstd * cw[j]; }
}

__device__ __forceinline__ f32x4 ldx4(const char* row, bool is16, int idx) {
    if (is16) { const u32x2 w = *((const u32x2*)row + idx); return (f32x4){bf_lo(w.x), bf_hi(w.x), bf_lo(w.y), bf_hi(w.y)}; }
    return *((const f32x4*)row + idx); }
__device__ __forceinline__ void pool_pre_phase(AREF a, LAS unsigned char* lds, const float* modl, int l, int j, int wave, int lane_, int bx, int G, int nA, int nC) {
    int tid = threadIdx.x; asm volatile("" : "+v"(tid)); const int lane = tid & 63;
    LAS float* hs = (LAS float*)lds;
    const float* wn = a.in[I_NMIX] + (size_t)l * D; bf16_t* H = (bf16_t*)(a.ws + WS_H);
    const bool x16 = l != 0; const size_t rstr = x16 ? (size_t)D * 2 : (size_t)D * 4;
    const char* xpb = x16 ? (const char*)(a.ws + WS_XB) : (const char*)a.in[I_XP]; const char* xsb = x16 ? (const char*)(a.ws + WS_XB) + (size_t)NPR * rstr : (const char*)a.in[I_XS];
#define LDX(base_, row_, jj_) ldx4((base_) + (size_t)(row_) * rstr, x16, lane + 64 * (jj_))
    const int c0 = 2 * tid, w = 2 << (tid >> 7);
    const bool bal = nC > 0 && G == NPR / 64 && nA + nC <= G;
    const int s1 = (bal && bx >= nA && bx - nA < nC) ? bx - nA : -1;
    const int nstr = bal ? ((bx >= nC ? 1 : 0) + (s1 >= 0 ? 1 : 0)) : (NPR / 64 - bx + G - 1) / G;
    for (int qs = 0; qs < nstr; ++qs) {
        const int sidx = bal ? ((qs == 0 && bx >= nC) ? bx : s1) : bx + qs * G;
        const int row_s = sidx * 64, t_s = row_s & (SEQ - 1), cnd = row_s >> 11;
        const float* mp = modl + (size_t)cnd * MODW;
        f32x4 ca[4], cb[4];
#pragma unroll
        for (int jj = 0; jj < 4; ++jj) { const f32x4 w4 = *((const f32x4*)wn + lane + 64 * jj), s4 = *((const f32x4*)(mp + D) + lane + 64 * jj); cb[jj] = *((const f32x4*)mp + lane + 64 * jj); ca[jj] = w4 * (1.0f + s4); }
        f32x4 v[4][4];
#pragma unroll
        for (int q = 0; q < 4; ++q) { const int rr = -15 + wave + 8 * q; const bool ok = rr <= 15 && t_s + rr >= 0;
#pragma unroll
            for (int jj = 0; jj < 4; ++jj) v[q][jj] = ok ? LDX(xpb, row_s + (ok ? rr : 0), jj) : (f32x4){0.f, 0.f, 0.f, 0.f}; }
        __builtin_amdgcn_sched_barrier(0);
        f32x2 S = (f32x2){0.f, 0.f};
#pragma unroll
        for (int c = 0; c < 4; ++c) {
#pragma unroll
            for (int q = 0; q < (c == 0 ? 4 : 2); ++q) { const int rr = (c == 0 ? -15 : 16 * c) + wave + 8 * q;
                if (c != 0 || rr <= 15) { const int t = t_s + rr;
                    if (t >= 0) { float ss = 0.f;
#pragma unroll
                        for (int jj = 0; jj < 4; ++jj) ss += (v[q][jj].x * v[q][jj].x + v[q][jj].y * v[q][jj].y) + (v[q][jj].z * v[q][jj].z + v[q][jj].w * v[q][jj].w);
                        const float rstd = 1.0f / sqrtf(wave_sum(ss) * (1.f / D) + EPS);
#pragma unroll
                        for (int jj = 0; jj < 4; ++jj) v[q][jj] = v[q][jj] * rstd * ca[jj] + cb[jj]; }
                    LAS f32x4* dst = (LAS f32x4*)(hs + ((rr + 32) & 31) * D) + lane;
#pragma unroll
                    for (int jj = 0; jj < 4; ++jj) dst[64 * jj] = v[q][jj];
                    if (rr >= 0 && t >= SEQ - 15) { f32x4* o = (f32x4*)(a.out + O_NPP + ((size_t)(j * 8 + cnd) * 15 + (t - (SEQ - 15))) * D) + lane;
#pragma unroll
                        for (int jj = 0; jj < 4; ++jj) o[64 * jj] = v[q][jj]; }
                } }
            __syncthreads();
            if (c < 3) {
#pragma unroll
                for (int q = 0; q < 2; ++q)
#pragma unroll
                    for (int jj = 0; jj < 4; ++jj) v[q][jj] = LDX(xpb, row_s + 16 * (c + 1) + wave + 8 * q, jj); }
            __builtin_amdgcn_sched_barrier(0);
            for (int r = 16 * c; r < 16 * c + 16; ++r) {
                const f32x2 cur = *(const LAS f32x2*)(hs + ((r + 32) & 31) * D + c0);
                if (r == 0) { for (int q = 0; q < w; ++q) S += *(const LAS f32x2*)(hs + ((32 - q) & 31) * D + c0); }
                else S += cur - *(const LAS f32x2*)(hs + ((r - w + 32) & 31) * D + c0);
                const int tt = t_s + r + 1; const int nn = tt < w ? tt : w;
                const f32x2 p = S * (1.0f / (float)nn) - cur;
                *(unsigned*)(H + (size_t)(row_s + r) * D + c0) = cvt_pk_bf16(p.x, p.y);
            }
            __syncthreads();
        }
    }
    const int nlight = bal ? (nA - nC) + (G - nA - nC) : G;
    const int li = bal ? (bx < nC ? -1 : (bx < nA ? bx - nC : (bx >= nA + nC ? bx - (nA + nC) + (nA - nC) : -1))) : G - 1 - bx;
    for (int b = li; b >= 0 && b < NSM; b += nlight) {
        const int cnd = 8 + b; const float* mp = modl + (size_t)cnd * MODW;
        f32x4 v[2][4];
#pragma unroll
        for (int q = 0; q < 2; ++q) { const int i = wave + 8 * q; const float* src = a.in[I_SP] + ((size_t)(j * NSM + b) * 15 + (i < 15 ? i : 0)) * D;
#pragma unroll
            for (int jj = 0; jj < 4; ++jj) v[q][jj] = i < 15 ? *((const f32x4*)src + lane + 64 * jj) : LDX(xsb, b, jj); }
        __builtin_amdgcn_sched_barrier(0);
#pragma unroll
        for (int q = 0; q < 2; ++q) { const int i = wave + 8 * q;
            if (i == 15) { float ss = 0.f;
#pragma unroll
                for (int jj = 0; jj < 4; ++jj) ss += (v[q][jj].x * v[q][jj].x + v[q][jj].y * v[q][jj].y) + (v[q][jj].z * v[q][jj].z + v[q][jj].w * v[q][jj].w);
                const float rstd = 1.0f / sqrtf(wave_sum(ss) * (1.f / D) + EPS);
#pragma unroll
                for (int jj = 0; jj < 4; ++jj) { const f32x4 w4 = *((const f32x4*)wn + lane + 64 * jj), s4 = *((const f32x4*)(mp + D) + lane + 64 * jj), h4 = *((const f32x4*)mp + lane + 64 * jj); v[q][jj] = v[q][jj] * rstd * (w4 * (1.0f + s4)) + h4; } }
            LAS f32x4* dst = (LAS f32x4*)(hs + i * D) + lane;
#pragma unroll
            for (int jj = 0; jj < 4; ++jj) dst[64 * jj] = v[q][jj];
            if (i >= 1) { f32x4* o = (f32x4*)(a.out + O_NPS + ((size_t)(j * NSM + b) * 15 + (i - 1)) * D) + lane;
#pragma unroll
                for (int jj = 0; jj < 4; ++jj) o[64 * jj] = v[q][jj]; } }
        __syncthreads();
        { f32x2 S = (f32x2){0.f, 0.f};
            for (int q = 0; q < w; ++q) S += *(const LAS f32x2*)(hs + (15 - q) * D + c0);
            const f32x2 cur = *(const LAS f32x2*)(hs + 15 * D + c0);
            const f32x2 p = S * (1.0f / (float)w) - cur;
            *(unsigned*)(H + (size_t)(NPR + b) * D + c0) = cvt_pk_bf16(p.x, p.y); }
        __syncthreads();
    }
}
#undef LDX

__device__ __forceinline__ void spatial_phase(AREF a, LAS unsigned char* lds, int j, int gw, int wave, int lane_, int bx, int G) {
    int tid = threadIdx.x; asm volatile("" : "+v"(tid)); const int lane = tid & 63;
    const bf16_t* U = (const bf16_t*)(a.ws + WS_U); const bf16_t* V = (const bf16_t*)(a.ws + WS_V); bf16_t* B2 = (bf16_t*)(a.ws + WS_B2);
    const float* lng = a.in[I_GLG] + (size_t)j * D; const float* lnb = a.in[I_GLB] + (size_t)j * D;
    const float* bs = a.in[I_GBS] + (size_t)j * 8 * 128;
    const bf16_t* WS = (const bf16_t*)(a.ws + WS_WSP) + (size_t)j * 8 * 128 * 128;
    LAS f32x2* st = (LAS f32x2*)lds;
    LAS bf16_t* vt = (LAS bf16_t*)(lds + 1024);
    LAS bf16_t* wa = (LAS bf16_t*)(lds + 1024 + 128 * 136 * 2);
    constexpr int VLD = 136;
    for (int item = bx; item < 256; item += G) {
        const int ch = item >> 1, hq = item & 1, R0 = ch * 128;
        u32x4 w[16][2], wv[4][4];
        const int d8 = (tid & 15) * 8;
#pragma unroll
        for (int rr = 0; rr < 16; ++rr) { const u32x4* vp = (const u32x4*)(V + (size_t)(R0 + wave * 16 + rr) * D) + lane; w[rr][0] = vp[0]; w[rr][1] = vp[64]; }
#pragma unroll
        for (int gi = 0; gi < 4; ++gi)
#pragma unroll
            for (int ii = 0; ii < 4; ++ii) wv[gi][ii] = *(const u32x4*)(V + (size_t)(R0 + (tid >> 4) + 32 * ii) * D + (hq * 4 + gi) * 128 + d8);
        __builtin_amdgcn_sched_barrier(0);
#pragma unroll
        for (int rr = 0; rr < 16; ++rr) { float sm = 0.f, sq = 0.f;
#pragma unroll
            for (int q = 0; q < 2; ++q)
#pragma unroll
                for (int e = 0; e < 4; ++e) { const float lo = bf_lo(w[rr][q][e]), hi = bf_hi(w[rr][q][e]); sm += lo + hi; sq += lo * lo + hi * hi; }
            sm = wave_sum(sm); sq = wave_sum(sq);
            const float mean = sm * (1.f / D), var = sq * (1.f / D) - mean * mean;
            if (lane == 0) st[wave * 16 + rr] = (f32x2){mean, 1.0f / sqrtf((var > 0.f ? var : 0.f) + EPS)}; }
        __syncthreads();
#pragma unroll
        for (int gi = 0; gi < 4; ++gi) {
            const int g = hq * 4 + gi;
            const bf16_t* wsg = WS + (size_t)g * 128 * 128;
            u32x4 wreg[4];
#pragma unroll
            for (int ii = 0; ii < 4; ++ii) wreg[ii] = *(const u32x4*)(wsg + (size_t)((tid >> 4) + 32 * ii) * 128 + d8);
            { const f32x4 ga = *(const f32x4*)(lng + g * 128 + d8), gb = *(const f32x4*)(lng + g * 128 + d8 + 4), ba = *(const f32x4*)(lnb + g * 128 + d8), bb = *(const f32x4*)(lnb + g * 128 + d8 + 4);
#pragma unroll
                for (int ii = 0; ii < 4; ++ii) { const int s = (tid >> 4) + 32 * ii; const u32x4 w = wv[gi][ii]; const f32x2 ms = st[s];
                    u32x4 o;
                    o.x = cvt_pk_bf16((bf_lo(w.x) - ms.x) * ms.y * ga.x + ba.x, (bf_hi(w.x) - ms.x) * ms.y * ga.y + ba.y);
                    o.y = cvt_pk_bf16((bf_lo(w.y) - ms.x) * ms.y * ga.z + ba.z, (bf_hi(w.y) - ms.x) * ms.y * ga.w + ba.w);
                    o.z = cvt_pk_bf16((bf_lo(w.z) - ms.x) * ms.y * gb.x + bb.x, (bf_hi(w.z) - ms.x) * ms.y * gb.y + bb.y);
                    o.w = cvt_pk_bf16((bf_lo(w.w) - ms.x) * ms.y * gb.z + bb.z, (bf_hi(w.w) - ms.x) * ms.y * gb.w + bb.w);
                    *(LAS u32x4*)(vt + s * VLD + d8) = o; }
#pragma unroll
                for (int ii = 0; ii < 4; ++ii) *(LAS u32x4*)(wa + ((tid >> 4) + 32 * ii) * VLD + d8) = wreg[ii]; }
            __syncthreads();
            {
                const int fr = lane & 15, fq = lane >> 4;
                bf16x8 af[8][4]; u32x2 uw[8]; float bt[8];
#pragma unroll
                for (int mb = 0; mb < 8; ++mb) {
#pragma unroll
                    for (int ks = 0; ks < 4; ++ks) if (ks <= (mb >> 1)) af[mb][ks] = *(const LAS bf16x8*)(wa + (mb * 16 + fr) * VLD + ks * 32 + fq * 8);
                    uw[mb] = *(const u32x2*)(U + (size_t)(R0 + mb * 16 + fr) * D + g * 128 + wave * 16 + 4 * fq); bt[mb] = bs[g * 128 + mb * 16 + fr]; }
                bf16x8 bfr[4];
#pragma unroll
                for (int ks = 0; ks < 4; ++ks)
#pragma unroll
                    for (int e = 0; e < 8; ++e) bfr[ks][e] = (short)vt[(ks * 32 + fq * 8 + e) * VLD + wave * 16 + fr];
                __builtin_amdgcn_sched_barrier(0);
#pragma unroll
                for (int mb = 0; mb < 8; ++mb) {
                    f32x4 acc = (f32x4){0.f, 0.f, 0.f, 0.f};
#pragma unroll
                    for (int ks = 0; ks < 4; ++ks) if (ks <= (mb >> 1)) acc = __builtin_amdgcn_mfma_f32_16x16x32_bf16(bfr[ks], af[mb][ks], acc, 0, 0, 0);
                    const size_t off = (size_t)(R0 + mb * 16 + fr) * D + g * 128 + wave * 16 + 4 * fq;
                    u32x2 o; o.x = cvt_pk_bf16(bf_lo(uw[mb].x) * (acc[0] + bt[mb]), bf_hi(uw[mb].x) * (acc[1] + bt[mb])); o.y = cvt_pk_bf16(bf_lo(uw[mb].y) * (acc[2] + bt[mb]), bf_hi(uw[mb].y) * (acc[3] + bt[mb]));
                    *(u32x2*)(B2 + off) = o;
                }
            }
            __syncthreads();
        }
    }
    if (gw < NSM) {
        const int b = gw, row = NPR + b; const u32x4* vp = (const u32x4*)(V + (size_t)row * D) + lane;
        float vv[16]; float sm = 0.f, sq = 0.f;
#pragma unroll
        for (int q = 0; q < 2; ++q) { const u32x4 w = vp[64 * q];
#pragma unroll
            for (int e = 0; e < 4; ++e) { const float lo = bf_lo(w[e]), hi = bf_hi(w[e]); vv[q * 8 + 2 * e] = lo; vv[q * 8 + 2 * e + 1] = hi; sm += lo + hi; sq += lo * lo + hi * hi; } }
        sm = wave_sum(sm); sq = wave_sum(sq);
        const float mean = sm * (1.f / D), var = sq * (1.f / D) - mean * mean, rstd = 1.0f / sqrtf((var > 0.f ? var : 0.f) + EPS);
#pragma unroll
        for (int q = 0; q < 2; ++q) { const int c0 = lane * 8 + 512 * q, g = c0 >> 7;
            const float w00 = a.in[I_GWS][((size_t)(j * 8 + g) * 128) * 128], b0 = bs[g * 128];
            float vn[8], gt[8]; const u32x4 uw = *(const u32x4*)(U + (size_t)row * D + c0);
#pragma unroll
            for (int e = 0; e < 8; ++e) { vn[e] = (vv[q * 8 + e] - mean) * rstd * lng[c0 + e] + lnb[c0 + e]; const float uu = (e & 1) ? bf_hi(uw[e >> 1]) : bf_lo(uw[e >> 1]); gt[e] = uu * (w00 * vn[e] + b0); }
            float* nv = a.out + O_NV + ((size_t)(j * NSM + b)) * D + c0;
            *(f32x4*)nv = (f32x4){vn[0], vn[1], vn[2], vn[3]}; *(f32x4*)(nv + 4) = (f32x4){vn[4], vn[5], vn[6], vn[7]};
            u32x4 o; o.x = cvt_pk_bf16(gt[0], gt[1]); o.y = cvt_pk_bf16(gt[2], gt[3]); o.z = cvt_pk_bf16(gt[4], gt[5]); o.w = cvt_pk_bf16(gt[6], gt[7]);
            *(u32x4*)(B2 + (size_t)row * D + c0) = o; }
    }
}

#define OPQ int G = gridDim.x, bx = blockIdx.x, wave = wave0; asm volatile("" : "+s"(G), "+s"(bx), "+s"(wave)); const int gw = bx * 8 + wave, NGW = G * 8; (void)gw; (void)NGW;
#define GRID_BAR() xcd_barrier(bar)
#define KA (*kargs())
#define WSB(off) ((bf16_t*)(KA.ws + (off)))
#define MODP ((float*)(KA.ws + WS_MOD))
#define RSS(k) ((float*)(KA.ws + WS_RSS) + (size_t)(k) * RSTR)
#define CBG(k) ((float*)(KA.ws + WS_CBG) + (size_t)(k) * NCOND * 2 * FF)
#define CBI(k) ((float*)(KA.ws + WS_CBI) + (size_t)(k) * NCOND * 2 * D)
template <int l>
__device__ __forceinline__ void layer_body(LAS unsigned char* lds, const XcdBarrier& bar, const int wave0) {
    constexpr int j = l >> 1;
    if constexpr ((l & 1) == 0) {
        { OPQ
            int nA = 0;
            if constexpr (l == 0) {
#pragma unroll 1
                for (int k = 0; k < 6; ++k) {
                    const int start = k < 4 ? 22 * k : 88 + 8 * (k - 4), c = (bx - start + 4 * G) % G, N = k < 4 ? 2 * FF : 2 * D;
                    pg8::Gemm g{WSB(WS_SHB) + (size_t)k * 256 * D, k < 4 ? WSB(WS_WGU) + (size_t)k * 2 * FF * D : WSB(WS_WIN) + (size_t)(k - 4) * 2 * D * D, 256, N, D, D, 0};
                    pg8::StaticOrder S; S.init(256, N, G, c);
                    pg8::EpiCbw E{k < 4 ? CBG(k) : CBI(k - 4), N};
                    pg8::gemm_phase<pg8::EpiCbw>(lds, g, S, E);
                }
#pragma unroll 1
                for (int jj = 0; jj < 2; ++jj) {
                    pg8::Gemm g{WSB(WS_WPO) + (size_t)jj * D * D, WSB(WS_WPG) + (size_t)jj * 4 * 65536, D, D, 256, D, 256};
                    pg8::StaticOrder S; S.init(D, D, G, (bx - 104 - 16 * jj + 4 * G) % G);
                    pg8::EpiBf16 E{WSB(WS_WEF) + (size_t)jj * D * D, WSB(WS_WEF) + (size_t)jj * D * D, nullptr, nullptr, nullptr, 0};
                    pg8::gemm_phase<pg8::EpiBf16>(lds, g, S, E);
                }
                nA = G < 136 ? G : 136;
            }
            pool_pre_phase(KA, lds, MODP + (size_t)l * 6 * D, l, j, wave, 0, bx, G, nA, l == 0 ? 104 : 0);
        }
        GRID_BAR();
        { OPQ
            pg8::Gemm g{WSB(WS_H), WSB(WS_WEF) + (size_t)j * D * D, NPR, D, D, D, 0}; pg8::StaticOrder S; S.init(NPR, D, G, bx);
            pg8::EpiResidT<true> E{l == 0 ? KA.in[I_XP] : nullptr, WSB(WS_XB), WSB(WS_XB), MODP + (size_t)l * 6 * D + 2 * D, WSB(WS_B2), KA.in[I_NFFN] + (size_t)l * D, MODP + (size_t)l * 6 * D + 4 * D, RSS(l)};
            pg8::gemm_phase<pg8::EpiResidT<true>>(lds, g, S, E);
            skinny_phase<0, 2, 4>(lds, Skinny{WSB(WS_H), D, 0, WSB(WS_WEF) + (size_t)j * D * D, D, D / 16, 0, G, bx},
                SkResid{l == 0 ? KA.in[I_XS] : nullptr, WSB(WS_XB), WSB(WS_XB), MODP + (size_t)l * 6 * D + 2 * D, WSB(WS_B2), KA.in[I_NFFN] + (size_t)l * D, MODP + (size_t)l * 6 * D + 4 * D, RSS(l)});
        }
        GRID_BAR();
    } else {
        { OPQ
            pg8::Gemm g{WSB(WS_H), WSB(WS_WIN) + (size_t)j * 2 * D * D, NPR, 2 * D, D, D, 0}; pg8::StaticOrder S; S.init(NPR, 2 * D, G, bx);
            pg8::EpiBf16 E{WSB(WS_U), WSB(WS_V), nullptr, RSS(4 + j), CBI(j), 2 * D};
            pg8::gemm_phase<pg8::EpiBf16>(lds, g, S, E);
            skinny_phase<0, 4, 4>(lds, Skinny{WSB(WS_H), D, 0, WSB(WS_WIN) + (size_t)j * 2 * D * D, D, 2 * D / 16, 0, G, bx}, SkBf16{WSB(WS_U), WSB(WS_V), nullptr, RSS(4 + j), CBI(j), 2 * D});
        }
        GRID_BAR();
        { OPQ spatial_phase(KA, lds, j, gw, wave, 0, bx, G); }
        GRID_BAR();
        { OPQ
            pg8::Gemm g{WSB(WS_B2), WSB(WS_WGO) + (size_t)j * D * D, NPR, D, D, D, 0}; pg8::StaticOrder S; S.init(NPR, D, G, bx);
            pg8::EpiResidT<true> E{nullptr, WSB(WS_XB), WSB(WS_XB), MODP + (size_t)l * 6 * D + 2 * D, WSB(WS_H), KA.in[I_NFFN] + (size_t)l * D, MODP + (size_t)l * 6 * D + 4 * D, RSS(l)};
            pg8::gemm_phase<pg8::EpiResidT<true>>(lds, g, S, E);
            skinny_phase<0, 2, 4>(lds, Skinny{WSB(WS_B2), D, 0, WSB(WS_WGO) + (size_t)j * D * D, D, D / 16, 0, G, bx},
                SkResid{nullptr, WSB(WS_XB), WSB(WS_XB), MODP + (size_t)l * 6 * D + 2 * D, WSB(WS_H), KA.in[I_NFFN] + (size_t)l * D, MODP + (size_t)l * 6 * D + 4 * D, RSS(l)});
        }
        GRID_BAR();
    }
    { OPQ
        pg8::Gemm g{WSB((l & 1) ? WS_H : WS_B2), WSB(WS_WGU) + (size_t)l * 2 * FF * D, NPR, 2 * FF, D, D, 0}; pg8::StaticOrder S; S.init(NPR, 2 * FF, G, bx);
        pg8::stage_swiglu_tables(lds, S, RSS(l), CBG(l));
        pg8::EpiSwiGLU E{WSB(WS_ACT), lds};
        pg8::gemm_phase<pg8::EpiSwiGLU>(lds, g, S, E);
        { const int extra = S.nwg % G; skinny_phase<2, 8, 2>(lds, Skinny{WSB((l & 1) ? WS_H : WS_B2), D, 0, WSB(WS_WGU) + (size_t)l * 2 * FF * D, D, FF / 16, extra, G - extra, bx}, SkSwiGLU{WSB(WS_ACT), RSS(l), CBG(l)}); }
    }
    GRID_BAR();
    { OPQ
        pg8::Gemm g{WSB(WS_ACT), WSB(WS_WDN) + (size_t)l * D * FF, NPR, D, FF, FF, 0}; pg8::StaticOrder S; S.init(NPR, D, G, bx);
        if constexpr ((l & 1) == 0) {
            pg8::EpiResidT<true> E{nullptr, WSB(WS_XB), WSB(WS_XB), MODP + (size_t)l * 6 * D + 5 * D, WSB(WS_H), KA.in[I_NMIX] + (size_t)(l + 1) * D, MODP + (size_t)(l + 1) * 6 * D + 1 * D, RSS(4 + j)};
            pg8::gemm_phase<pg8::EpiResidT<true>>(lds, g, S, E);
            skinny_phase<0, 2, 11>(lds, Skinny{WSB(WS_ACT), FF, 0, WSB(WS_WDN) + (size_t)l * D * FF, FF, D / 16, 0, G, bx},
                SkResid{nullptr, WSB(WS_XB), WSB(WS_XB), MODP + (size_t)l * 6 * D + 5 * D, WSB(WS_H), KA.in[I_NMIX] + (size_t)(l + 1) * D, MODP + (size_t)(l + 1) * 6 * D + 1 * D, RSS(4 + j)});
        } else {
            pg8::EpiResidT<false> E{nullptr, WSB(WS_XB), WSB(WS_XB), MODP + (size_t)l * 6 * D + 5 * D, nullptr, nullptr, nullptr, nullptr};
            pg8::gemm_phase<pg8::EpiResidT<false>>(lds, g, S, E);
            skinny_phase<0, 2, 11>(lds, Skinny{WSB(WS_ACT), FF, 0, WSB(WS_WDN) + (size_t)l * D * FF, FF, D / 16, 0, G, bx},
                SkResid{nullptr, WSB(WS_XB), WSB(WS_XB), MODP + (size_t)l * 6 * D + 5 * D, nullptr, nullptr, nullptr, nullptr});
        }
    }
    GRID_BAR();
}

__global__ void __launch_bounds__(512) mega_fwd(Args a_unused) {
    extern __shared__ __attribute__((aligned(16))) unsigned char lds_raw[];
    LAS unsigned char* lds = (LAS unsigned char*)lds_raw;
    cg::grid_group grid = cg::this_grid();
    const int wave0 = __builtin_amdgcn_readfirstlane((int)threadIdx.x >> 6);
    volatile LAS unsigned* MISC = (volatile LAS unsigned*)(lds + 131072 + 320);
    if (threadIdx.x < 32) MISC[threadIdx.x] = 0u;
    __syncthreads();
    const XcdBarrier bar = xcd_barrier_post((unsigned*)kargs()->ws, MISC + 8);
    if (kargs()->ws == nullptr) grid.sync();

    { OPQ prologue1_phase(KA, lds, gw, NGW, wave, (int)threadIdx.x & 63); }
    GRID_BAR();
    { OPQ
        pg8::Gemm g{WSB(WS_SC), WSB(WS_WADA), 256, MODW, D, D, 0}; pg8::StaticOrder S; S.init(256, MODW, G, bx);
        pg8::EpiAda E{MODP, KA.in[I_BADA], WSB(WS_SHB)};
        pg8::gemm_phase<pg8::EpiAda>(lds, g, S, E);
        prologue2_phase(KA, lds, wave, (int)threadIdx.x & 63, bx, G);
    }
    GRID_BAR();
    layer_body<0>(lds, bar, wave0); layer_body<1>(lds, bar, wave0); layer_body<2>(lds, bar, wave0); layer_body<3>(lds, bar, wave0);
    { OPQ final_phase(WSB(WS_XB), KA.out, KA.in[I_NFIN], gw, NGW, (int)threadIdx.x & 63); }
}

extern "C" void kernel_launch(void* const* d_in, const int* in_sizes, int n_in, void* d_out, int out_size, void* d_ws, size_t ws_size, hipStream_t stream) {
    static int grid = 0;
    if (grid == 0) {
        if (n_in != 22 || ws_size < WS_END) { fprintf(stderr, "kernel_launch: expected 22 inputs and >= %zu bytes of workspace; got %d, %zu\n", (size_t)WS_END, n_in, ws_size); grid = -1; return; }
        int dev = 0, cus = 0, per_cu = 0;
        hipGetDevice(&dev); hipDeviceGetAttribute(&cus, hipDeviceAttributeMultiprocessorCount, dev);
        if (hipFuncSetAttribute((const void*)mega_fwd, hipFuncAttributeMaxDynamicSharedMemorySize, LDS_BYTES) != hipSuccess) { fprintf(stderr, "kernel_launch: hipFuncSetAttribute failed\n"); grid = -1; return; }
        if (hipOccupancyMaxActiveBlocksPerMultiprocessor(&per_cu, (const void*)mega_fwd, 512, LDS_BYTES) != hipSuccess || per_cu < 1) { fprintf(stderr, "kernel_launch: occupancy query says %d\n", per_cu); per_cu = 1; }
        (void)hipGetLastError();
        grid = cus * per_cu;
    }
    if (grid < 0) return;
    Args a{};
    for (int i = 0; i < 22; ++i) a.in[i] = (const float*)d_in[i];
    a.out = (float*)d_out; a.ws = (unsigned char*)d_ws;
    void* args[] = {&a};
    if (hipMemsetAsync(d_ws, 0, 65536, stream) != hipSuccess) { fprintf(stderr, "kernel_launch: memset of barrier words failed\n"); return; }
    hipError_t e = hipLaunchCooperativeKernel((const void*)mega_fwd, dim3(grid), dim3(512), args, LDS_BYTES, stream);
    if (e != hipSuccess) fprintf(stderr, "cooperative launch failed: %s (grid %d)\n", hipGetErrorString(e), grid);
}
```

```cpp
#include <hip/hip_runtime.h>
#include <hip/hip_cooperative_groups.h>
#include <cstdio>
namespace cg = cooperative_groups;

#define LAS __attribute__((address_space(3)))
typedef unsigned short bf16_t;
typedef short bf16x8 __attribute__((ext_vector_type(8)));
typedef float f32x4 __attribute__((ext_vector_type(4)));
typedef float f32x2 __attribute__((ext_vector_type(2)));
typedef unsigned u32x4 __attribute__((ext_vector_type(4)));
typedef unsigned u32x2 __attribute__((ext_vector_type(2)));

constexpr int D = 1024, NPR = 16384, NSM = 128, MR = NPR + NSM  , MP = 16640  , FF = 2816, SEQ = 2048;
constexpr int NCOND = 136, MODW = 4 * 6 * D  ;
constexpr float EPS = 1e-6f;
constexpr size_t O_YP = 0, O_YS = (size_t)NPR * D, O_NPP = O_YS + (size_t)NSM * D, O_NPS = O_NPP + (size_t)2 * 8 * 15 * D, O_NV = O_NPS + (size_t)2 * 128 * 15 * D;
constexpr size_t MiB = 1u << 20;
constexpr size_t WS_WADA = 1 * MiB;
constexpr size_t WS_WGU = WS_WADA + (size_t)MODW * D * 2;
constexpr size_t WS_WDN = WS_WGU + (size_t)4 * 2 * FF * D * 2;
constexpr size_t WS_WIN = WS_WDN + (size_t)4 * D * FF * 2;
constexpr size_t WS_WGO = WS_WIN + (size_t)2 * 2 * D * D * 2;
constexpr size_t WS_WPO = WS_WGO + (size_t)2 * D * D * 2;
constexpr size_t WS_WPG = WS_WPO + (size_t)2 * D * D * 2;
constexpr size_t WS_WSP = WS_WPG + (size_t)2 * 4 * 256 * 256 * 2;
constexpr size_t WS_SC = WS_WSP + (size_t)2 * 8 * 128 * 128 * 2;
constexpr size_t WS_MOD = WS_SC + (size_t)256 * D * 2;
constexpr size_t WS_H = WS_MOD + (size_t)NCOND * MODW * 4;
constexpr size_t WS_B2 = WS_H + (size_t)MP * D * 2;
constexpr size_t WS_ACT = WS_B2 + (size_t)MP * D * 2;
constexpr size_t WS_U = WS_ACT, WS_V = WS_ACT + (size_t)MP * D * 2;
constexpr size_t WS_RSS = WS_ACT + (size_t)MP * FF * 2;
constexpr int RSTR = NPR * 4 + NSM * 32;
constexpr size_t WS_SHB = WS_RSS + (size_t)6 * RSTR * 4;
constexpr size_t WS_CBG = WS_SHB + (size_t)6 * 256 * D * 2;
constexpr size_t WS_CBI = WS_CBG + (size_t)4 * NCOND * 2 * FF * 4;
constexpr size_t WS_WEF = WS_CBI + (size_t)2 * NCOND * 2 * D * 4;
constexpr size_t WS_XB = WS_WEF + (size_t)2 * D * D * 2;
constexpr size_t WS_END = WS_XB + (size_t)MP * D * 2;
constexpr int LDS_BYTES = 147456;

__device__ __forceinline__ unsigned cvt_pk_bf16(float lo, float hi) { unsigned r; asm volatile("v_cvt_pk_bf16_f32 %0, %1, %2" : "=v"(r) : "v"(lo), "v"(hi)); return r; }
__device__ __forceinline__ float bf_lo(unsigned w) { return __uint_as_float(w << 16); }
__device__ __forceinline__ float bf_hi(unsigned w) { return __uint_as_float(w & 0xffff0000u); }
template <int CTRL> __device__ __forceinline__ float dpp_f(float v) { return __int_as_float(__builtin_amdgcn_mov_dpp(__float_as_int(v), CTRL, 0xf, 0xf, true)); }
__device__ __forceinline__ float wave_sum(float v) {
    v += dpp_f<0xB1>(v);
    v += dpp_f<0x4E>(v);
    v += dpp_f<0x141>(v);
    v += dpp_f<0x140>(v);
    const int iv = __float_as_int(v);
    return (__int_as_float(__builtin_amdgcn_readlane(iv, 0)) + __int_as_float(__builtin_amdgcn_readlane(iv, 16))) + (__int_as_float(__builtin_amdgcn_readlane(iv, 32)) + __int_as_float(__builtin_amdgcn_readlane(iv, 48)));
}
__device__ __forceinline__ int cond_of(int row) { int c = row < NPR ? (row >> 11) : 8 + (row - NPR); return c > NCOND - 1 ? NCOND - 1 : c; }
__device__ __forceinline__ float silu_f(float g) { return g * __builtin_amdgcn_rcpf(1.0f + __expf(-g)); }

namespace pg8 {
constexpr int BM = 256, BK = 64, HALF = 128, HTB = HALF * BK * 2, STAGE_BYTES = 8 * HTB, NXCD = 8, WGM = 8;
__device__ __forceinline__ int lds_byte(int r, int c) { const int st = (r >> 4) * 2 + (c >> 5), rr = r & 15, cc = c & 31, ob = rr * 64 + cc * 2; return st * 1024 + (ob ^ (((ob >> 9) & 1) << 5)); }
__device__ __forceinline__ void stage_rc(int b, int& R, int& C) { const int st = b / 1024, sb = b % 1024, swz = sb ^ (((sb >> 9) & 1) << 5); R = (st >> 1) * 16 + swz / 64; C = (st & 1) * 32 + (swz % 64) / 2; }
__device__ __forceinline__ int perm32(int rho) { const int n = rho >> 4, i = rho & 15; return 8 * (i >> 2) + 4 * n + (i & 3); }

struct Unit { int pm, pn, idx; };
struct Gemm { const bf16_t* A; const bf16_t* Bt; int M, N, K, lda, a_pn_step; };

struct StaticOrder {
    int nM, nN, nwg, G, c;
    __device__ void init(int M, int N, int G_, int c_) { nM = M / BM; nN = N / BM; nwg = nM * nN; G = G_; c = c_; }
    __device__ bool next(int i, Unit& u) const {
        const long L = (long)i * G + c; if (L >= nwg) return false;
        int wgid = (int)L; { const int q = nwg / NXCD, r = nwg % NXCD, xcd = wgid % NXCD, off = wgid / NXCD; wgid = (xcd < r ? xcd * (q + 1) : r * (q + 1) + (xcd - r) * q) + off; }
        const int nig = WGM * nN, gid = wgid / nig, fm = gid * WGM, gsz = (nM - fm) < WGM ? (nM - fm) : WGM;
        u.pm = fm + ((wgid % nig) % gsz); u.pn = (wgid % nig) / gsz; u.idx = i; return true;
    }
};


struct EpiAda {
    static constexpr bool PERM = false, AFTER_DRAIN = false;
    float* C; const float* bias; bf16_t* shb;
    __device__ __forceinline__ void operator()(const f32x4 (&acc)[2][2][4][2], const Unit& u, int wr, int wc, int fr, int fq) const {
        const int row0 = u.pm * BM + wr * 64 + fr, col0 = u.pn * BM + wc * 32 + 4 * fq;
        const int tc = u.pn * BM, l = tc / (6 * D), chunk = (tc % (6 * D)) >> 10, cc0 = (tc & (D - 1)) + wc * 32 + 4 * fq;
        const int shidx = chunk == 3 ? l : ((chunk == 0 && (l & 1)) ? 4 + (l >> 1) : -1);
#pragma unroll
        for (int ai = 0; ai < 2; ++ai)
#pragma unroll
            for (int m = 0; m < 4; ++m) { const int row = row0 + ai * HALF + m * 16;
#pragma unroll
                for (int bj = 0; bj < 2; ++bj)
#pragma unroll
                    for (int n = 0; n < 2; ++n) { const f32x4 v = acc[ai][bj][m][n] + *(const f32x4*)(bias + col0 + bj * HALF + n * 16);
                        if (row < NCOND) *(f32x4*)(C + (size_t)row * MODW + col0 + bj * HALF + n * 16) = v;
                        if (shidx >= 0) { u32x2 w; w.x = cvt_pk_bf16(v[0], v[1]); w.y = cvt_pk_bf16(v[2], v[3]); *(u32x2*)(shb + ((size_t)shidx * 256 + row) * D + cc0 + bj * HALF + n * 16) = w; } } }
    }
};
struct EpiCbw {
    static constexpr bool PERM = false, AFTER_DRAIN = false;
    float* C; int ldc;
    __device__ __forceinline__ void operator()(const f32x4 (&acc)[2][2][4][2], const Unit& u, int wr, int wc, int fr, int fq) const {
        const int row0 = u.pm * BM + wr * 64 + fr, col0 = u.pn * BM + wc * 32 + 4 * fq;
#pragma unroll
        for (int ai = 0; ai < 2; ++ai)
#pragma unroll
            for (int m = 0; m < 4; ++m) { const int row = row0 + ai * HALF + m * 16;
                if (row < NCOND) {
#pragma unroll
                    for (int bj = 0; bj < 2; ++bj)
#pragma unroll
                        for (int n = 0; n < 2; ++n) *(f32x4*)(C + (size_t)row * ldc + col0 + bj * HALF + n * 16) = acc[ai][bj][m][n]; } }
    }
};
template <bool XA>
struct EpiResidT {
    static constexpr bool PERM = true, AFTER_DRAIN = XA;
    const float* xin32; const bf16_t* xinb; bf16_t* xb; const float* modg;
    bf16_t* xa; const float* wnn; const float* scn; float* rowss;
    __device__ __forceinline__ void body(const f32x4 (&acc)[2][2][4][2], const Unit& u, int wr, int wc, int fr, int fq, LAS float* P) const {
        const int row0 = u.pm * BM + wr * 64 + fr, col0 = u.pn * BM + wc * 32 + 8 * fq;
        const float* gp = modg + (size_t)(u.pm >> 3) * MODW + col0;
        f32x4 gv[2][2], ca[2][2];
#pragma unroll
        for (int bj = 0; bj < 2; ++bj)
#pragma unroll
            for (int n = 0; n < 2; ++n) { gv[bj][n] = *(const f32x4*)(gp + bj * HALF + 4 * n);
                if (XA) ca[bj][n] = *(const f32x4*)(wnn + col0 + bj * HALF + 4 * n) * (1.0f + *(const f32x4*)(scn + (size_t)(u.pm >> 3) * MODW + col0 + bj * HALF + 4 * n)); }
#pragma unroll
        for (int ai = 0; ai < 2; ++ai)
#pragma unroll
            for (int mp = 0; mp < 2; ++mp) {
                f32x4 xv[2][2][2];
                if (xin32) {
#pragma unroll
                    for (int mm = 0; mm < 2; ++mm) { const float* xp = xin32 + (size_t)(row0 + ai * HALF + (2 * mp + mm) * 16) * D + col0;
#pragma unroll
                        for (int bj = 0; bj < 2; ++bj)
#pragma unroll
                            for (int n = 0; n < 2; ++n) xv[mm][bj][n] = __builtin_nontemporal_load((const f32x4*)(xp + bj * HALF + 4 * n)); }
                } else {
                    u32x4 xw[2][2];
#pragma unroll
                    for (int mm = 0; mm < 2; ++mm)
#pragma unroll
                        for (int bj = 0; bj < 2; ++bj) xw[mm][bj] = *(const u32x4*)(xinb + (size_t)(row0 + ai * HALF + (2 * mp + mm) * 16) * D + col0 + bj * HALF);
#pragma unroll
                    for (int mm = 0; mm < 2; ++mm)
#pragma unroll
                        for (int bj = 0; bj < 2; ++bj) { xv[mm][bj][0] = (f32x4){bf_lo(xw[mm][bj].x), bf_hi(xw[mm][bj].x), bf_lo(xw[mm][bj].y), bf_hi(xw[mm][bj].y)};
                            xv[mm][bj][1] = (f32x4){bf_lo(xw[mm][bj].z), bf_hi(xw[mm][bj].z), bf_lo(xw[mm][bj].w), bf_hi(xw[mm][bj].w)}; }
                }
                __builtin_amdgcn_sched_barrier(0);
#pragma unroll
                for (int mm = 0; mm < 2; ++mm) { const size_t ro = (size_t)(row0 + ai * HALF + (2 * mp + mm) * 16) * D + col0; float sq = 0.f;
#pragma unroll
                    for (int bj = 0; bj < 2; ++bj) {
                        const f32x4 x0 = xv[mm][bj][0] + gv[bj][0] * acc[ai][bj][2 * mp + mm][0], x1 = xv[mm][bj][1] + gv[bj][1] * acc[ai][bj][2 * mp + mm][1];
                        u32x4 w; w.x = cvt_pk_bf16(x0[0], x0[1]); w.y = cvt_pk_bf16(x0[2], x0[3]); w.z = cvt_pk_bf16(x1[0], x1[1]); w.w = cvt_pk_bf16(x1[2], x1[3]);
                        *(u32x4*)(xb + ro + bj * HALF) = w;
                        if (XA) { sq += ((x0[0] * x0[0] + x0[1] * x0[1]) + (x0[2] * x0[2] + x0[3] * x0[3])) + ((x1[0] * x1[0] + x1[1] * x1[1]) + (x1[2] * x1[2] + x1[3] * x1[3]));
                            const f32x4 h0 = x0 * ca[bj][0], h1 = x1 * ca[bj][1];
                            u32x4 hw; hw.x = cvt_pk_bf16(h0[0], h0[1]); hw.y = cvt_pk_bf16(h0[2], h0[3]); hw.z = cvt_pk_bf16(h1[0], h1[1]); hw.w = cvt_pk_bf16(h1[2], h1[3]);
                            *(u32x4*)(xa + ro + bj * HALF) = hw; } }
                    if (XA) { sq += __int_as_float(__builtin_amdgcn_ds_swizzle(__float_as_int(sq), 0x401F));
                        if ((fq & 1) == 0) P[(ai * HALF + wr * 64 + (2 * mp + mm) * 16 + fr) * 8 + wc * 2 + (fq >> 1)] = sq; } }
                __builtin_amdgcn_sched_barrier(0);
            }
    }
    __device__ __forceinline__ void operator()(const f32x4 (&acc)[2][2][4][2], const Unit& u, int wr, int wc, int fr, int fq) const { body(acc, u, wr, wc, fr, fq, nullptr); }
    __device__ __forceinline__ void fused(const f32x4 (&acc)[2][2][4][2], const Unit& u, int wr, int wc, int fr, int fq, LAS unsigned char* lds, int tid) const {
        LAS float* P = (LAS float*)lds;
        body(acc, u, wr, wc, fr, fq, P);
        __syncthreads();
        if (tid < 256) { const f32x4 p0 = *(const LAS f32x4*)(P + tid * 8), p1 = *(const LAS f32x4*)(P + tid * 8 + 4);
            rowss[(size_t)(u.pm * BM + tid) * 4 + u.pn] = ((p0[0] + p0[1]) + (p0[2] + p0[3])) + ((p1[0] + p1[1]) + (p1[2] + p1[3])); }
        __syncthreads();
    }
};
struct EpiBf16 {
    static constexpr bool PERM = true, AFTER_DRAIN = false;
    bf16_t* O; bf16_t* O2; const float* scale; const float* rowss; const float* cbw; int ldcb;
    __device__ __forceinline__ void operator()(const f32x4 (&acc)[2][2][4][2], const Unit& u, int wr, int wc, int fr, int fq) const {
        const int row0 = u.pm * BM + wr * 64 + fr; bf16_t* base = u.pn >= 4 ? O2 : O; const int col0 = (u.pn & 3) * BM + wc * 32 + 8 * fq;
        f32x4 sv[2][2], bv[2][2];
#pragma unroll
        for (int bj = 0; bj < 2; ++bj)
#pragma unroll
            for (int n = 0; n < 2; ++n) { sv[bj][n] = scale ? *(const f32x4*)(scale + col0 + bj * HALF + 4 * n) : (f32x4){1.f, 1.f, 1.f, 1.f};
                bv[bj][n] = rowss ? *(const f32x4*)(cbw + (size_t)(u.pm >> 3) * ldcb + u.pn * BM + wc * 32 + 8 * fq + bj * HALF + 4 * n) : (f32x4){0.f, 0.f, 0.f, 0.f}; }
        float rs[2][4];
#pragma unroll
        for (int ai = 0; ai < 2; ++ai)
#pragma unroll
            for (int m = 0; m < 4; ++m) { rs[ai][m] = 1.0f;
                if (rowss) { const f32x4 p = *(const f32x4*)(rowss + (size_t)(row0 + ai * HALF + m * 16) * 4); rs[ai][m] = __builtin_amdgcn_rsqf(((p[0] + p[1]) + (p[2] + p[3])) * (1.f / D) + EPS); } }
        __builtin_amdgcn_sched_barrier(0);
#pragma unroll
        for (int ai = 0; ai < 2; ++ai)
#pragma unroll
            for (int m = 0; m < 4; ++m) { const int row = row0 + ai * HALF + m * 16; bf16_t* rowp = base + (size_t)row * D + col0;
#pragma unroll
                for (int bj = 0; bj < 2; ++bj) { const f32x4 v0 = acc[ai][bj][m][0] * sv[bj][0] * rs[ai][m] + bv[bj][0], v1 = acc[ai][bj][m][1] * sv[bj][1] * rs[ai][m] + bv[bj][1];
                    u32x4 w; w.x = cvt_pk_bf16(v0[0], v0[1]); w.y = cvt_pk_bf16(v0[2], v0[3]); w.z = cvt_pk_bf16(v1[0], v1[1]); w.w = cvt_pk_bf16(v1[2], v1[3]);
                    *(u32x4*)(rowp + bj * HALF) = w; } }
    }
};
constexpr int TAB_OFF = 131072 + 1024, TAB_STRIDE = 2048, TAB_MAX = 7;
struct EpiSwiGLU {
    static constexpr bool PERM = true, AFTER_DRAIN = false;
    bf16_t* O; LAS unsigned char* lds;
    __device__ __forceinline__ void operator()(const f32x4 (&acc)[2][2][4][2], const Unit& u, int wr, int wc, int fr, int fq) const {
        const int row0 = u.pm * BM + wr * 64 + fr, col0 = u.pn * HALF + wc * 32 + 8 * fq;
        const LAS float* T = (const LAS float*)(lds + TAB_OFF + u.idx * TAB_STRIDE);
        const f32x4 cg0 = *(const LAS f32x4*)(T + 256 + wc * 32 + 8 * fq), cg1 = *(const LAS f32x4*)(T + 256 + wc * 32 + 8 * fq + 4), cu0 = *(const LAS f32x4*)(T + 256 + HALF + wc * 32 + 8 * fq), cu1 = *(const LAS f32x4*)(T + 256 + HALF + wc * 32 + 8 * fq + 4);
#pragma unroll
        for (int ai = 0; ai < 2; ++ai)
#pragma unroll
            for (int m = 0; m < 4; ++m) { const int row = row0 + ai * HALF + m * 16; bf16_t* rowp = O + (size_t)row * FF + col0;
                const float r1 = T[ai * HALF + wr * 64 + m * 16 + fr];
                const f32x4 g0 = acc[ai][0][m][0] * r1 + cg0, g1 = acc[ai][0][m][1] * r1 + cg1, u0 = acc[ai][1][m][0] * r1 + cu0, u1 = acc[ai][1][m][1] * r1 + cu1;
                u32x4 w; w.x = cvt_pk_bf16(silu_f(g0[0]) * u0[0], silu_f(g0[1]) * u0[1]); w.y = cvt_pk_bf16(silu_f(g0[2]) * u0[2], silu_f(g0[3]) * u0[3]);
                w.z = cvt_pk_bf16(silu_f(g1[0]) * u1[0], silu_f(g1[1]) * u1[1]); w.w = cvt_pk_bf16(silu_f(g1[2]) * u1[2], silu_f(g1[3]) * u1[3]);
                *(u32x4*)rowp = w; }
    }
};
__device__ __forceinline__ void stage_swiglu_tables(LAS unsigned char* lds, const StaticOrder& S, const float* rowss, const float* cbw) {
    int tid = threadIdx.x; asm volatile("" : "+v"(tid));
    f32x4 p[TAB_MAX]; float c[TAB_MAX]; bool ok[TAB_MAX];
#pragma unroll
    for (int i = 0; i < TAB_MAX; ++i) { Unit u; ok[i] = S.next(i, u); p[i] = (f32x4){1.f, 1.f, 1.f, 1.f}; c[i] = 0.f;
        if (ok[i]) { if (tid < 256) p[i] = *(const f32x4*)(rowss + (size_t)(u.pm * BM + tid) * 4); else c[i] = cbw[(size_t)(u.pm >> 3) * (2 * FF) + u.pn * BM + (tid - 256)]; } }
    __builtin_amdgcn_sched_barrier(0);
#pragma unroll
    for (int i = 0; i < TAB_MAX; ++i) if (ok[i]) ((LAS float*)(lds + TAB_OFF + i * TAB_STRIDE))[tid] = tid < 256 ? __builtin_amdgcn_rsqf(((p[i][0] + p[i][1]) + (p[i][2] + p[i][3])) * (1.f / D) + EPS) : c[i];
    __syncthreads();
}

template <class Epi>
__device__ __forceinline__ void gemm_phase(LAS unsigned char* lds, const Gemm g, const StaticOrder& S, const Epi& E) {
    int tid_o = threadIdx.x; asm volatile("" : "+v"(tid_o));
    const int tid = tid_o, wid = __builtin_amdgcn_readfirstlane(tid >> 6), lane = tid & 63, wr = wid >> 2, wc = wid & 3, fr = lane & 15, fq = lane >> 4;
    const int K = g.K, nt = K / BK, lda = g.lda;
    unsigned voffA[2], voffB[2];
#pragma unroll
    for (int i = 0; i < 2; ++i) { int R, C; stage_rc(tid * 16 + i * 8192, R, C); const int Rb = Epi::PERM ? ((R & ~31) + perm32(R & 31)) : R;
        voffA[i] = (unsigned)(R * lda + C) * 2u; voffB[i] = (unsigned)(Rb * K + C) * 2u; }
    const size_t kstep = (size_t)(BK * 2);
    const size_t hstepA = (size_t)HALF * lda * 2, hstepB = (size_t)HALF * K * 2;
    const size_t tstepA = 2 * hstepA, tstepB = 2 * hstepB;
    const unsigned ldsw = (unsigned)wid * 1024u;
    const int aoff = lds_byte(wr * 64 + fr, fq * 8), boff = lds_byte(wc * 32 + fr, fq * 8);
#define PG8_SA(b, h) (((b) * 2 + (h)) * HTB)
#define PG8_SB(b, h) ((4 + (b) * 2 + (h)) * HTB)
#define PG8_STAGE(bufoff, gbase, voff) do { _Pragma("unroll") for (int _i = 0; _i < 2; ++_i) \
        __builtin_amdgcn_global_load_lds((const unsigned*)((const char*)(gbase) + (voff)[_i]), (LAS unsigned*)(lds + (bufoff) + ldsw + _i * 8192), 16, 0, 0); } while (0)
#define PG8_LDA(dst, b, h) do { _Pragma("unroll") for (int m = 0; m < 4; ++m) _Pragma("unroll") for (int k = 0; k < 2; ++k) dst[m][k] = *(const LAS bf16x8*)(lds + PG8_SA(b, h) + aoff + m * 2048 + k * 1024); } while (0)
#define PG8_LDB(dst, b, h) do { _Pragma("unroll") for (int n = 0; n < 2; ++n) _Pragma("unroll") for (int k = 0; k < 2; ++k) dst[n][k] = *(const LAS bf16x8*)(lds + PG8_SB(b, h) + boff + n * 2048 + k * 1024); } while (0)
#define PG8_MMA(ai, bj, At, Bt) do { __builtin_amdgcn_s_setprio(1); _Pragma("unroll") for (int m = 0; m < 4; ++m) _Pragma("unroll") for (int n = 0; n < 2; ++n) _Pragma("unroll") for (int k = 0; k < 2; ++k) \
        acc[ai][bj][m][n] = __builtin_amdgcn_mfma_f32_16x16x32_bf16(Bt[n][k], At[m][k], acc[ai][bj][m][n], 0, 0, 0); __builtin_amdgcn_s_setprio(0); } while (0)
#define PG8_WAIT_V(n) asm volatile("s_waitcnt vmcnt(" #n ")" ::: "memory")
#define PG8_WAIT_L(n) asm volatile("s_waitcnt lgkmcnt(" #n ")" ::: "memory")
#define PG8_BAR __builtin_amdgcn_s_barrier()
#define PG8_SCHED __builtin_amdgcn_sched_barrier(0)
    Unit cur, nxt; int ui = 0;
    if (!S.next(0, cur)) return;
    f32x4 acc[2][2][4][2];
#pragma unroll
    for (int a = 0; a < 2; ++a)
#pragma unroll
        for (int b = 0; b < 2; ++b)
#pragma unroll
            for (int m = 0; m < 4; ++m)
#pragma unroll
                for (int n = 0; n < 2; ++n) acc[a][b][m][n] = (f32x4){0.f, 0.f, 0.f, 0.f};
    bf16x8 At[4][2], B0[2][2], B1[2][2];
    const char* cA = (const char*)g.A + (size_t)cur.pm * tstepA + (size_t)cur.pn * g.a_pn_step * 2; const char* cB = (const char*)g.Bt + (size_t)cur.pn * tstepB;
    PG8_STAGE(PG8_SB(0, 0), cB, voffB); PG8_STAGE(PG8_SA(0, 0), cA, voffA); PG8_STAGE(PG8_SB(0, 1), cB + hstepB, voffB); PG8_STAGE(PG8_SA(0, 1), cA + hstepA, voffA);
    if (wr == 1) PG8_BAR;
    PG8_WAIT_V(4); PG8_BAR;
    PG8_STAGE(PG8_SB(1, 0), cB + kstep, voffB); PG8_STAGE(PG8_SA(1, 0), cA + kstep, voffA); PG8_STAGE(PG8_SB(1, 1), cB + hstepB + kstep, voffB);
    PG8_WAIT_V(6); PG8_BAR;
    for (;;) {
        const bool has_next = S.next(ui + 1, nxt);
        const char* nA = has_next ? (const char*)g.A + (size_t)nxt.pm * tstepA + (size_t)nxt.pn * g.a_pn_step * 2 : cA; const char* nB = has_next ? (const char*)g.Bt + (size_t)nxt.pn * tstepB : cB;
        for (int t = 0; t < nt; t += 2) {
            const bool last = (t == nt - 2);
            const char* a1 = cA + (size_t)(t + 1) * kstep;
            const char* a2 = last ? nA : cA + (size_t)(t + 2) * kstep; const char* b2 = last ? nB : cB + (size_t)(t + 2) * kstep;
            const char* a3 = a2 + kstep; const char* b3 = b2 + kstep;
            PG8_LDB(B0, 0, 0); PG8_SCHED; PG8_LDA(At, 0, 0); PG8_STAGE(PG8_SA(1, 1), a1 + hstepA, voffA);
            PG8_WAIT_L(8); PG8_BAR; PG8_WAIT_L(0); PG8_MMA(0, 0, At, B0); PG8_BAR; PG8_SCHED;
            PG8_LDB(B1, 0, 1); PG8_STAGE(PG8_SB(0, 0), b2, voffB);
            PG8_BAR; PG8_WAIT_L(0); PG8_MMA(0, 1, At, B1); PG8_BAR;
            PG8_LDA(At, 0, 1); PG8_STAGE(PG8_SA(0, 0), a2, voffA);
            PG8_BAR; PG8_WAIT_L(0); PG8_MMA(1, 0, At, B0); PG8_BAR; PG8_SCHED;
            PG8_STAGE(PG8_SB(0, 1), b2 + hstepB, voffB);
            PG8_WAIT_V(6); PG8_BAR; PG8_MMA(1, 1, At, B1); PG8_BAR;
            PG8_LDB(B0, 1, 0); PG8_SCHED; PG8_LDA(At, 1, 0); PG8_STAGE(PG8_SA(0, 1), a2 + hstepA, voffA);
            PG8_WAIT_L(8); PG8_BAR; PG8_WAIT_L(0); PG8_MMA(0, 0, At, B0); PG8_BAR; PG8_SCHED;
            PG8_LDB(B1, 1, 1); PG8_STAGE(PG8_SB(1, 0), b3, voffB);
            PG8_BAR; PG8_WAIT_L(0); PG8_MMA(0, 1, At, B1); PG8_BAR;
            PG8_LDA(At, 1, 1); PG8_STAGE(PG8_SA(1, 0), a3, voffA);
            PG8_BAR; PG8_WAIT_L(0); PG8_MMA(1, 0, At, B0); PG8_BAR; PG8_SCHED;
            PG8_STAGE(PG8_SB(1, 1), b3 + hstepB, voffB);
            PG8_WAIT_V(6); PG8_BAR; PG8_MMA(1, 1, At, B1); PG8_BAR;
        }
        if constexpr (!Epi::AFTER_DRAIN) E(acc, cur, wr, wc, fr, fq);
        if (!has_next) break;
#pragma unroll
        for (int a = 0; a < 2; ++a)
#pragma unroll
            for (int b = 0; b < 2; ++b)
#pragma unroll
                for (int m = 0; m < 4; ++m)
#pragma unroll
                    for (int n = 0; n < 2; ++n) acc[a][b][m][n] = (f32x4){0.f, 0.f, 0.f, 0.f};
        cur = nxt; cA = nA; cB = nB; ++ui;
    }
    PG8_WAIT_V(0);
    if (wr == 0) PG8_BAR;
    PG8_BAR;
    if constexpr (Epi::AFTER_DRAIN) E.fused(acc, cur, wr, wc, fr, fq, lds, tid);
#undef PG8_SA
#undef PG8_SB
#undef PG8_STAGE
#undef PG8_LDA
#undef PG8_LDB
#undef PG8_MMA
#undef PG8_WAIT_V
#undef PG8_WAIT_L
#undef PG8_BAR
#undef PG8_SCHED
}
}


struct Skinny { const bf16_t* A; int lda, a_grp; const bf16_t* Bt; int K, ntask, first, navail, bx; };
struct SkResid { const float* xin32; const bf16_t* xinb; bf16_t* xb; const float* modg;
    bf16_t* xa; const float* wnn; const float* scn; float* rowss;
    __device__ __forceinline__ void operator()(const f32x4& r, const f32x4&, int row, int col) const {
        const int cnd = 8 + row - NPR; const f32x4 gv = *(const f32x4*)(modg + (size_t)cnd * MODW + col);
        f32x4 xo;
        if (xin32) xo = *(const f32x4*)(xin32 + (size_t)(row - NPR) * D + col);
        else { const u32x2 w = *(const u32x2*)(xinb + (size_t)row * D + col); xo = (f32x4){bf_lo(w.x), bf_hi(w.x), bf_lo(w.y), bf_hi(w.y)}; }
        const f32x4 xn = xo + gv * r;
        { u32x2 w; w.x = cvt_pk_bf16(xn[0], xn[1]); w.y = cvt_pk_bf16(xn[2], xn[3]); *(u32x2*)(xb + (size_t)row * D + col) = w; }
        if (xa) { const f32x4 hv = xn * (*(const f32x4*)(wnn + col) * (1.0f + *(const f32x4*)(scn + (size_t)cnd * MODW + col)));
            u32x2 w; w.x = cvt_pk_bf16(hv[0], hv[1]); w.y = cvt_pk_bf16(hv[2], hv[3]); *(u32x2*)(xa + (size_t)row * D + col) = w;
            float sq = (xn[0] * xn[0] + xn[1] * xn[1]) + (xn[2] * xn[2] + xn[3] * xn[3]); sq += __int_as_float(__builtin_amdgcn_ds_swizzle(__float_as_int(sq), 0x401F));
            if (((col >> 2) & 1) == 0) __hip_atomic_fetch_add(rowss + NPR * 4 + (row - NPR) * 32, sq, __ATOMIC_RELAXED, __HIP_MEMORY_SCOPE_AGENT); } } };
struct SkBf16 { bf16_t* O; bf16_t* O2; const float* scale; const float* rowss; const float* cbw; int ldcb;
    __device__ __forceinline__ void operator()(const f32x4& r, const f32x4&, int row, int col) const {
        bf16_t* base = col >= D ? O2 : O; const int c = col & (D - 1); f32x4 v = r; if (scale) v = v * *(const f32x4*)(scale + c);
        if (rowss) v = v * (1.0f / sqrtf(rowss[NPR * 4 + (row - NPR) * 32] * (1.f / D) + EPS)) + *(const f32x4*)(cbw + (size_t)(8 + row - NPR) * ldcb + col);
        u32x2 w; w.x = cvt_pk_bf16(v[0], v[1]); w.y = cvt_pk_bf16(v[2], v[3]); *(u32x2*)(base + (size_t)row * D + c) = w; } };
struct SkSwiGLU { bf16_t* O; const float* rowss; const float* cbw;
    __device__ __forceinline__ void operator()(const f32x4& g_, const f32x4& u_, int row, int col) const {
        const float rs = 1.0f / sqrtf(rowss[NPR * 4 + (row - NPR) * 32] * (1.f / D) + EPS); const float* cp = cbw + (size_t)(8 + row - NPR) * (2 * FF) + (col >> 7) * 256 + (col & 127);
        const f32x4 g = g_ * rs + *(const f32x4*)cp, u = u_ * rs + *(const f32x4*)(cp + 128);
        u32x2 w; w.x = cvt_pk_bf16(silu_f(g[0]) * u[0], silu_f(g[1]) * u[1]); w.y = cvt_pk_bf16(silu_f(g[2]) * u[2], silu_f(g[3]) * u[3]); *(u32x2*)(O + (size_t)row * FF + col) = w; } };

template <int MODE, int RB, int CH, class EP>
__device__ __forceinline__ void skinny_phase(LAS unsigned char* lds, const Skinny s, const EP& ep) {
    int tid = threadIdx.x; asm volatile("" : "+v"(tid));
    const int lane = tid & 63, wave = __builtin_amdgcn_readfirstlane(tid >> 6), fr = lane & 15, fq = lane >> 4;
    const int kw = s.K >> 3;
    const int bid = s.bx - s.first;
    if (bid < 0) return;
    constexpr int NRG = 8 / RB;
    LAS f32x4* red = (LAS f32x4*)lds;
    for (int t = bid; t < s.ntask * NRG; t += s.navail) {
        const int n0 = (t / NRG) * 16, rg = t % NRG, rbase = NPR + rg * RB * 16;
        const char* Ab = (const char*)s.A; const char* Bb = (const char*)s.Bt;
        const unsigned aoff = (unsigned)((rbase + fr) * s.lda + (s.a_grp ? (n0 >> 8) * 256 : 0) + wave * kw + fq * 8) * 2u, astr = (unsigned)(16 * s.lda) * 2u;
        const int brow = (MODE == 2) ? ((n0 >> 7) * 256 + (n0 & 127)) : n0;
        const unsigned boff = (unsigned)((brow + fr) * s.K + wave * kw + fq * 8) * 2u, bup = (unsigned)(128 * s.K) * 2u;
        f32x4 acc[RB], acc2[RB];
#pragma unroll
        for (int mb = 0; mb < RB; ++mb) { acc[mb] = (f32x4){0.f, 0.f, 0.f, 0.f}; acc2[mb] = (f32x4){0.f, 0.f, 0.f, 0.f}; }
#pragma unroll 1
        for (int k = 0; k < kw; k += 32 * CH) {
            const int ns = (kw - k) >> 5;
            bf16x8 bb[CH], bb2[CH], af[CH][RB];
#pragma unroll
            for (int c = 0; c < CH; ++c) if (c < ns) {
                bb[c] = *(const bf16x8*)(Bb + (boff + (unsigned)(k + 32 * c) * 2u));
                if (MODE == 2) bb2[c] = *(const bf16x8*)(Bb + (boff + bup + (unsigned)(k + 32 * c) * 2u));
#pragma unroll
                for (int mb = 0; mb < RB; ++mb) af[c][mb] = *(const bf16x8*)(Ab + (aoff + (unsigned)mb * astr + (unsigned)(k + 32 * c) * 2u)); }
            __builtin_amdgcn_sched_barrier(0);
#pragma unroll
            for (int c = 0; c < CH; ++c) if (c < ns) {
#pragma unroll
                for (int mb = 0; mb < RB; ++mb) { acc[mb] = __builtin_amdgcn_mfma_f32_16x16x32_bf16(bb[c], af[c][mb], acc[mb], 0, 0, 0);
                    if (MODE == 2) acc2[mb] = __builtin_amdgcn_mfma_f32_16x16x32_bf16(bb2[c], af[c][mb], acc2[mb], 0, 0, 0); } }
            __builtin_amdgcn_sched_barrier(0);
        }
#pragma unroll
        for (int mb = 0; mb < RB; ++mb) { red[(wave * RB + mb) * 64 + lane] = acc[mb]; if (MODE == 2) red[8 * RB * 64 + (wave * RB + mb) * 64 + lane] = acc2[mb]; }
        __syncthreads();
        if (wave < RB) {
            f32x4 r = (f32x4){0.f, 0.f, 0.f, 0.f}, r2 = (f32x4){0.f, 0.f, 0.f, 0.f};
#pragma unroll
            for (int w = 0; w < 8; ++w) { r += red[(w * RB + wave) * 64 + lane]; if (MODE == 2) r2 += red[8 * RB * 64 + (w * RB + wave) * 64 + lane]; }
            ep(r, r2, rbase + wave * 16 + fr, n0 + 4 * fq);
        }
        __syncthreads();
    }
}


struct Args { const float* in[22]; float* out; unsigned char* ws; };
#define AREF const __attribute__((address_space(4))) Args&
__device__ __forceinline__ const __attribute__((address_space(4))) Args* kargs() {
    auto kp = __builtin_amdgcn_kernarg_segment_ptr(); asm volatile("" : "+s"(kp)); return (const __attribute__((address_space(4))) Args*)kp; }
#define XB_TMO      128
#define XB_XCNT(j)  (256  + 64 * (j))
#define XB_XSUB(j)  (1280 + 64 * (j))
#define XB_XGEN(j)  (2304 + 64 * (j))
#define XB_TOP      3328
#define XB_TOPGEN   3392
#define XCD_BAR_WORDS 3456
#define XB_SPIN_CAP (1u << 18)
__device__ __forceinline__ unsigned xb_ld(unsigned* p)              { return __hip_atomic_load(p, __ATOMIC_RELAXED, __HIP_MEMORY_SCOPE_AGENT); }
__device__ __forceinline__ unsigned xb_add(unsigned* p, unsigned v) { return __hip_atomic_fetch_add(p, v, __ATOMIC_RELAXED, __HIP_MEMORY_SCOPE_AGENT); }
__device__ __forceinline__ unsigned xb_xcc_id() { return (unsigned)__builtin_amdgcn_s_getreg((3 << 11) | 20) & 0xFu; }
#define XB_SPIN(cond, bar) do { unsigned _sp = 0; while (cond) { __builtin_amdgcn_s_sleep(1); \
    if ((++_sp & 255u) == 0u) { if (xb_ld(&(bar)[XB_TMO])) break; if (_sp > XB_SPIN_CAP) { atomicAdd(&(bar)[XB_TMO], 1u); break; } } } } while (0)
struct XcdBarrier { unsigned* bar; unsigned x; volatile LAS unsigned* st; };
__device__ __forceinline__ XcdBarrier xcd_barrier_post(unsigned* bar, volatile LAS unsigned* st) {
    XcdBarrier b; b.bar = bar; b.x = xb_xcc_id(); b.st = st;
    if (threadIdx.x == 0) (void)xb_add(&bar[XB_XCNT(b.x)], 1u);
    return b;
}
__device__ __forceinline__ void xcd_barrier_complete(unsigned* bar, unsigned x, unsigned& nloc, unsigned& nx) {
    const unsigned G = gridDim.x * gridDim.y * gridDim.z;
    unsigned sum, cnt, mine, sp = 0u;
    for (;;) {
        sum = 0u; cnt = 0u; mine = 0u;
#pragma unroll
        for (unsigned j = 0; j < 16; ++j) { const unsigned c = xb_ld(&bar[XB_XCNT(j)]); sum += c; cnt += (c > 0u) ? 1u : 0u; mine = (j == x) ? c : mine; }
        if (sum == G) break;
        __builtin_amdgcn_s_sleep(1);
        if ((++sp & 255u) == 0u) { if (xb_ld(&bar[XB_TMO])) break; if (sp > XB_SPIN_CAP) { atomicAdd(&bar[XB_TMO], 1u); break; } }
    }
    nloc = mine > 0u ? mine : 1u; nx = cnt > 0u ? cnt : 1u;
}
__device__ __forceinline__ void xcd_barrier(const XcdBarrier& b) {
    asm volatile("s_waitcnt vmcnt(0)" ::: "memory");
    __syncthreads();
    if (threadIdx.x == 0) {
        unsigned* bar = (unsigned*)kargs()->ws;
        __builtin_amdgcn_s_waitcnt(0);
        unsigned nloc = b.st[0], nx = b.st[1];
        const unsigned bxcc = xb_xcc_id();
        if (nloc == 0u) { xcd_barrier_complete(bar, bxcc, nloc, nx); b.st[0] = nloc; b.st[1] = nx; }
        const unsigned old = xb_add(&bar[XB_XSUB(bxcc)], 1u);
        const unsigned gen = old / nloc;
        if (old + 1u == (gen + 1u) * nloc) {
            __builtin_amdgcn_fence(__ATOMIC_RELEASE, "agent");
            asm volatile("s_waitcnt vmcnt(0)" ::: "memory");
            const unsigned og = xb_add(&bar[XB_TOP], 1u);
            const unsigned tg = og / nx;
            if (og + 1u == (tg + 1u) * nx) xb_add(&bar[XB_TOPGEN], 1u);
            else XB_SPIN(xb_ld(&bar[XB_TOPGEN]) == tg, bar);
            __builtin_amdgcn_fence(__ATOMIC_ACQUIRE, "agent");
            xb_add(&bar[XB_XGEN(bxcc)], 1u);
            asm volatile("s_waitcnt vmcnt(0)" ::: "memory");
        } else {
            XB_SPIN(xb_ld(&bar[XB_XGEN(bxcc)]) == gen, bar);
            __builtin_amdgcn_fence(__ATOMIC_ACQUIRE, "agent");
            asm volatile("s_waitcnt vmcnt(0)" ::: "memory");
        }
    }
    __syncthreads();
}
enum { I_XP = 0, I_XS, I_SP, I_CP, I_CS, I_WADA, I_BADA, I_NMIX, I_NFFN, I_NFIN, I_PWG, I_PSC, I_PWO, I_GWIN, I_GLG, I_GLB, I_GWS, I_GBS, I_GWO, I_FG, I_FU, I_FD };

#define LDS_WAIT() asm volatile("s_waitcnt lgkmcnt(0)" ::: "memory")

struct TrItem { const float* W; int N; bf16_t* WT; int ldt, k0, n0, drow0; };
__device__ __forceinline__ void tr_load(const TrItem& t, int lane, f32x4 (&v)[8]) {
#pragma unroll
    for (int i = 0; i < 8; ++i) v[i] = __builtin_nontemporal_load((const f32x4*)(t.W + (size_t)(t.k0 + (lane >> 3) + 8 * i) * t.N + t.n0 + (lane & 7) * 4));
}
__device__ __forceinline__ void tr_store(const TrItem& t, int lane, const f32x4 (&v)[8], LAS float* scr) {
#pragma unroll
    for (int i = 0; i < 8; ++i) { LAS float* s = scr + ((lane >> 3) + 8 * i) * 33 + (lane & 7) * 4; s[0] = v[i][0]; s[1] = v[i][1]; s[2] = v[i][2]; s[3] = v[i][3]; }
    LDS_WAIT(); asm volatile("" ::: "memory");
    const int c = lane & 7;
#pragma unroll
    for (int j = 0; j < 4; ++j) { const int n = (lane >> 3) + 8 * j; const LAS float* s = scr + (8 * c) * 33 + n;
        u32x4 o; o.x = cvt_pk_bf16(s[0 * 33], s[1 * 33]); o.y = cvt_pk_bf16(s[2 * 33], s[3 * 33]); o.z = cvt_pk_bf16(s[4 * 33], s[5 * 33]); o.w = cvt_pk_bf16(s[6 * 33], s[7 * 33]);
        *(u32x4*)(t.WT + (size_t)(t.drow0 + n) * t.ldt + t.k0 + 8 * c) = o; }
    LDS_WAIT(); asm volatile("" ::: "memory");
}

__device__ __forceinline__ float load_row_rstd(const float* xrow, int lane, f32x4 (&v)[4]) {
    const f32x4* xr = (const f32x4*)xrow + lane; float s = 0.f;
#pragma unroll
    for (int j = 0; j < 4; ++j) { v[j] = xr[64 * j]; s += (v[j].x * v[j].x + v[j].y * v[j].y) + (v[j].z * v[j].z + v[j].w * v[j].w); }
    return 1.0f / sqrtf(wave_sum(s) * (1.f / D) + EPS);
}
__device__ __forceinline__ void mod_row(f32x4 (&v)[4], float rstd, const float* wn, const float* sc, const float* sh, int lane) {
#pragma unroll
    for (int j = 0; j < 4; ++j) { const f32x4 w4 = *((const f32x4*)wn + lane + 64 * j), s4 = *((const f32x4*)sc + lane + 64 * j), h4 = *((const f32x4*)sh + lane + 64 * j);
        v[j] = v[j] * rstd * w4 * (1.0f + s4) + h4; }
}

__device__ __forceinline__ void prologue1_phase(AREF a, LAS unsigned char* lds, int gw, int NGW, int wave, int lane) {
    unsigned char* ws = a.ws;
    LAS float* scr = (LAS float*)(lds + wave * 16384);
    constexpr int I_ADA = (D / 64) * (6 * D / 32);
    {
        auto decode = [&](int it) { int r = it; const int l = r / I_ADA; r -= l * I_ADA; const int nblk = 6 * D / 32, kb = r / nblk, nb = r % nblk;
            return TrItem{a.in[I_WADA] + (size_t)l * D * 6 * D, 6 * D, (bf16_t*)(ws + WS_WADA) + (size_t)l * 6 * D * D, D, kb * 64, nb * 32, nb * 32}; };
        int it = gw;
        if (it < 4 * I_ADA) {
            TrItem cur = decode(it); f32x4 v[8]; tr_load(cur, lane, v);
            for (;;) {
                const int itn = it + NGW; const bool has = itn < 4 * I_ADA;
                TrItem nx = cur; f32x4 vn[8];
                if (has) { nx = decode(itn); tr_load(nx, lane, vn); }
                __builtin_amdgcn_sched_barrier(0);
                tr_store(cur, lane, v, scr);
                if (!has) break;
                cur = nx; it = itn;
#pragma unroll
                for (int i = 0; i < 8; ++i) v[i] = vn[i];
            }
        }
    }
    for (int row = gw; row < 256; row += NGW) {
        u32x2* o = (u32x2*)((bf16_t*)(ws + WS_SC) + (size_t)row * D) + lane;
        if (row < NCOND) { const float* cp = row < 8 ? a.in[I_CP] + (size_t)row * D : a.in[I_CS] + (size_t)(row - 8) * D;
#pragma unroll
            for (int j = 0; j < 4; ++j) { const f32x4 c4 = *((const f32x4*)cp + lane + 64 * j); u32x2 w; w.x = cvt_pk_bf16(c4.x / (1.f + __expf(-c4.x)), c4.y / (1.f + __expf(-c4.y))); w.y = cvt_pk_bf16(c4.z / (1.f + __expf(-c4.z)), c4.w / (1.f + __expf(-c4.w))); o[64 * j] = w; } }
        else {
#pragma unroll
            for (int j = 0; j < 4; ++j) o[64 * j] = (u32x2){0u, 0u}; }
    }
    for (int row = gw; row < 2 * 4 * 256; row += NGW) { const int jg = row >> 8; const f32x4 w4 = *((const f32x4*)(a.in[I_PWG] + (size_t)row * 256) + lane), s4 = *((const f32x4*)(a.in[I_PSC] + (size_t)jg * 256) + lane);
        u32x2 o; o.x = cvt_pk_bf16(w4.x * s4.x, w4.y * s4.y); o.y = cvt_pk_bf16(w4.z * s4.z, w4.w * s4.w); ((u32x2*)((bf16_t*)(ws + WS_WPG) + (size_t)row * 256))[lane] = o; }
    for (int i = gw * 64 + lane; i < 6 * RSTR / 4; i += NGW * 64) ((f32x4*)(ws + WS_RSS))[i] = (f32x4){0.f, 0.f, 0.f, 0.f};
    for (int row = gw; row < 2 * 8 * 128; row += NGW) { const int t = row & 127; const float* src = a.in[I_GWS] + (size_t)row * 128; const f32x2 w2 = *((const f32x2*)src + lane);
        const int s0 = 2 * lane; ((unsigned*)((bf16_t*)(ws + WS_WSP) + (size_t)row * 128))[lane] = cvt_pk_bf16(s0 <= t ? w2.x : 0.f, s0 + 1 <= t ? w2.y : 0.f); }
}
constexpr int CTR_WORD = 8192;
__device__ __forceinline__ void prologue2_phase(AREF a, LAS unsigned char* lds, int wave, int lane, int bx, int G) {
    unsigned char* ws = a.ws;
    LAS float* scr = (LAS float*)(lds + wave * 16384);
    constexpr int I_GU = (D / 64) * (FF / 32);
    constexpr int I_DN = (FF / 64) * (D / 32);
    constexpr int I_IN = (D / 64) * (2 * D / 32);
    constexpr int I_SQ = (D / 64) * (D / 32);
    constexpr int NITEMS = 4 * I_SQ + 2 * I_IN + 8 * I_GU + 4 * I_DN;
    const int nA = G < 96 ? G : 96, TOT = (nA + 4 * (G - nA)) * 8;
    const int nslot = bx < nA ? 1 : 4, sbase = bx < nA ? bx * 8 + wave : nA * 8 + ((bx - nA) * 8 + wave) * 4;
#define P2_ITEM(n_) (sbase + (nslot == 4 ? ((n_) >> 2) * TOT + ((n_) & 3) : (n_) * TOT))
    auto decode = [&](int it) {
        int r = it;
        if (r < 4 * I_SQ) { const int lm = r / I_SQ; r -= lm * I_SQ; const int l = lm & 1, po = (lm >> 1) ^ 1; const int nblk = D / 32, kb = r / nblk, nb = r % nblk;
            return TrItem{a.in[po ? I_PWO : I_GWO] + (size_t)l * D * D, D, (bf16_t*)(ws + (po ? WS_WPO : WS_WGO)) + (size_t)l * D * D, D, kb * 64, nb * 32, nb * 32}; }
        r -= 4 * I_SQ;
        if (r < 2 * I_IN) { const int l = r / I_IN; r -= l * I_IN; const int nblk = 2 * D / 32, kb = r / nblk, nb = r % nblk;
            return TrItem{a.in[I_GWIN] + (size_t)l * D * 2 * D, 2 * D, (bf16_t*)(ws + WS_WIN) + (size_t)l * 2 * D * D, D, kb * 64, nb * 32, nb * 32}; }
        r -= 2 * I_IN;
        if (r < 8 * I_GU) { const int lm = r / I_GU; r -= lm * I_GU; const int l = lm >> 1, up = lm & 1; const int nblk = FF / 32, kb = r / nblk, nb = r % nblk, n0 = nb * 32;
            return TrItem{a.in[up ? I_FU : I_FG] + (size_t)l * D * FF, FF, (bf16_t*)(ws + WS_WGU) + (size_t)l * 2 * FF * D, D, kb * 64, n0, (n0 >> 7) * 256 + (n0 & 127) + up * 128}; }
        r -= 8 * I_GU;
        { const int l = r / I_DN; r -= l * I_DN; const int nblk = D / 32, kb = r / nblk, nb = r % nblk;
            return TrItem{a.in[I_FD] + (size_t)l * FF * D, D, (bf16_t*)(ws + WS_WDN) + (size_t)l * D * FF, FF, kb * 64, nb * 32, nb * 32}; } };
    int n = 0, it = P2_ITEM(0);
    if (it < NITEMS) {
        TrItem cur = decode(it); f32x4 v[8]; tr_load(cur, lane, v);
        for (;;) {
            ++n; const int itn = P2_ITEM(n); const bool has = itn < NITEMS;
            TrItem nx = cur; f32x4 vn[8];
            if (has) { nx = decode(itn); tr_load(nx, lane, vn); }
            __builtin_amdgcn_sched_barrier(0);
            tr_store(cur, lane, v, scr);
            if (!has) break;
            cur = nx;
#pragma unroll
            for (int i = 0; i < 8; ++i) v[i] = vn[i];
        }
    }
#undef P2_ITEM
}

__device__ __forceinline__ void norm_phase(const float* x, const float* wn, const float* modl, int shi, int sci, bf16_t* H, int gw, int NGW, int lane_) {
    int lane = lane_; asm volatile("" : "+v"(lane));
    for (int r0 = gw * 8; r0 < NPR; r0 += NGW * 8) {
        const float* mp = modl + (size_t)(r0 >> 11) * MODW;
        f32x4 ca[4], cb[4];
#pragma unroll
        for (int j = 0; j < 4; ++j) { const f32x4 w4 = *((const f32x4*)wn + lane + 64 * j), s4 = *((const f32x4*)(mp + sci * D) + lane + 64 * j); cb[j] = *((const f32x4*)(mp + shi * D) + lane + 64 * j); ca[j] = w4 * (1.0f + s4); }
        {
            f32x4 v[8][4];
#pragma unroll
            for (int q = 0; q < 8; ++q)
#pragma unroll
                for (int j = 0; j < 4; ++j) v[q][j] = *((const f32x4*)(x + (size_t)(r0 + q) * D) + lane + 64 * j);
            __builtin_amdgcn_sched_barrier(0);
            float ss[8];
#pragma unroll
            for (int q = 0; q < 8; ++q) { float t = 0.f;
#pragma unroll
                for (int j = 0; j < 4; ++j) t += (v[q][j].x * v[q][j].x + v[q][j].y * v[q][j].y) + (v[q][j].z * v[q][j].z + v[q][j].w * v[q][j].w);
                ss[q] = t; }
#pragma unroll
            for (int q = 0; q < 8; ++q) ss[q] = wave_sum(ss[q]);
#pragma unroll
            for (int q = 0; q < 8; ++q) { const float rstd = 1.0f / sqrtf(ss[q] * (1.f / D) + EPS); u32x2* o = (u32x2*)(H + (size_t)(r0 + q) * D) + lane;
#pragma unroll
                for (int j = 0; j < 4; ++j) { const f32x4 h = v[q][j] * rstd * ca[j] + cb[j]; u32x2 w; w.x = cvt_pk_bf16(h.x, h.y); w.y = cvt_pk_bf16(h.z, h.w); o[64 * j] = w; } }
        }
    }
    for (int row = NPR + gw; row < MR; row += NGW) {
        f32x4 v[4]; const float rstd = load_row_rstd(x + (size_t)row * D, lane, v);
        const float* mp = modl + (size_t)cond_of(row) * MODW;
        mod_row(v, rstd, wn, mp + sci * D, mp + shi * D, lane);
        u32x2* o = (u32x2*)(H + (size_t)row * D) + lane;
#pragma unroll
        for (int j = 0; j < 4; ++j) { u32x2 w; w.x = cvt_pk_bf16(v[j].x, v[j].y); w.y = cvt_pk_bf16(v[j].z, v[j].w); o[64 * j] = w; }
    }
}
__device__ __forceinline__ void final_phase(const bf16_t* xb, float* y, const float* wn, int gw, int NGW, int lane_) {
    int lane = lane_; asm volatile("" : "+v"(lane));
    f32x4 cw[4];
#pragma unroll
    for (int j = 0; j < 4; ++j) cw[j] = *((const f32x4*)wn + lane + 64 * j);
    const bool has_s = gw < NSM; u32x2 sw[4];
    if (has_s) {
#pragma unroll
        for (int j = 0; j < 4; ++j) sw[j] = *((const u32x2*)(xb + (size_t)(NPR + gw) * D) + lane + 64 * j); }
    for (int r0 = gw * 4; r0 < NPR; r0 += NGW * 4) {
        u32x2 w[4][4];
#pragma unroll
        for (int q = 0; q < 4; ++q)
#pragma unroll
            for (int j = 0; j < 4; ++j) w[q][j] = __builtin_nontemporal_load((const u32x2*)(xb + (size_t)(r0 + q) * D) + lane + 64 * j);
        __builtin_amdgcn_sched_barrier(0);
        f32x4 v[4][4]; float ss[4];
#pragma unroll
        for (int q = 0; q < 4; ++q) { float t = 0.f;
#pragma unroll
            for (int j = 0; j < 4; ++j) { v[q][j] = (f32x4){bf_lo(w[q][j].x), bf_hi(w[q][j].x), bf_lo(w[q][j].y), bf_hi(w[q][j].y)}; t += (v[q][j].x * v[q][j].x + v[q][j].y * v[q][j].y) + (v[q][j].z * v[q][j].z + v[q][j].w * v[q][j].w); }
            ss[q] = t; }
#pragma unroll
        for (int q = 0; q < 4; ++q) ss[q] = wave_sum(ss[q]);
#pragma unroll
        for (int q = 0; q < 4; ++q) { const float rstd = 1.0f / sqrtf(ss[q] * (1.f / D) + EPS); f32x4* o = (f32x4*)(y + (size_t)(r0 + q) * D) + lane;
#pragma unroll
            for (int j = 0; j < 4; ++j) o[64 * j] = v[q][j] * rstd * cw[j]; }
    }
    if (has_s) { float t = 0.f; f32x4 sv[4];
#pragma unroll
        for (int j = 0; j < 4; ++j) { sv[j] = (f32x4){bf_lo(sw[j].x), bf_hi(sw[j].x), bf_lo(sw[j].y), bf_hi(sw[j].y)}; t += (sv[j].x * sv[j].x + sv[j].y * sv[j].y) + (sv[j].z * sv[j].z + sv[j].w * sv[j].w); }
        const float rstd = 1.0f / sqrtf(wave_sum(t) * (1.f / D) + EPS); f32x4* o = (f32x4*)(y + (size_t)(NPR + gw) * D) + lane;
#pragma unroll
        for (int j = 0; j < 4; ++j) o[64 * j] = sv[j] * rstd * cw[j]; }
}

__device__ __forceinline__ f32x4 ldx4(const char* row, bool is16, int idx) {
    if (is16) { const u32x2 w = *((const u32x2*)row + idx); return (f32x4){bf_lo(w.x), bf_hi(w.x), bf_lo(w.y), bf_hi(w.y)}; }
    return *((const f32x4*)row + idx); }
__device__ __forceinline__ void pool_pre_phase(AREF a, LAS unsigned char* lds, const float* modl, int l, int j, int wave, int lane_, int bx, int G, int nA, int nC) {
    int tid = threadIdx.x; asm volatile("" : "+v"(tid)); const int lane = tid & 63;
    LAS float* hs = (LAS float*)lds;
    const float* wn = a.in[I_NMIX] + (size_t)l * D; bf16_t* H = (bf16_t*)(a.ws + WS_H);
    const bool x16 = l != 0; const size_t rstr = x16 ? (size_t)D * 2 : (size_t)D * 4;
    const char* xpb = x16 ? (const char*)(a.ws + WS_XB) : (const char*)a.in[I_XP]; const char* xsb = x16 ? (const char*)(a.ws + WS_XB) + (size_t)NPR * rstr : (const char*)a.in[I_XS];
#define LDX(base_, row_, jj_) ldx4((base_) + (size_t)(row_) * rstr, x16, lane + 64 * (jj_))
    const int c0 = 2 * tid, w = 2 << (tid >> 7);
    const bool bal = nC > 0 && G == NPR / 64 && nA + nC <= G;
    const int s1 = (bal && bx >= nA && bx - nA < nC) ? bx - nA : -1;
    const int nstr = bal ? ((bx >= nC ? 1 : 0) + (s1 >= 0 ? 1 : 0)) : (NPR / 64 - bx + G - 1) / G;
    for (int qs = 0; qs < nstr; ++qs) {
        const int sidx = bal ? ((qs == 0 && bx >= nC) ? bx : s1) : bx + qs * G;
        const int row_s = sidx * 64, t_s = row_s & (SEQ - 1), cnd = row_s >> 11;
        const float* mp = modl + (size_t)cnd * MODW;
        f32x4 ca[4], cb[4];
#pragma unroll
        for (int jj = 0; jj < 4; ++jj) { const f32x4 w4 = *((const f32x4*)wn + lane + 64 * jj), s4 = *((const f32x4*)(mp + D) + lane + 64 * jj); cb[jj] = *((const f32x4*)mp + lane + 64 * jj); ca[jj] = w4 * (1.0f + s4); }
        f32x4 v[4][4];
#pragma unroll
        for (int q = 0; q < 4; ++q) { const int rr = -15 + wave + 8 * q; const bool ok = rr <= 15 && t_s + rr >= 0;
#pragma unroll
            for (int jj = 0; jj < 4; ++jj) v[q][jj] = ok ? LDX(xpb, row_s + (ok ? rr : 0), jj) : (f32x4){0.f, 0.f, 0.f, 0.f}; }
        __builtin_amdgcn_sched_barrier(0);
        f32x2 S = (f32x2){0.f, 0.f};
#pragma unroll
        for (int c = 0; c < 4; ++c) {
#pragma unroll
            for (int q = 0; q < (c == 0 ? 4 : 2); ++q) { const int rr = (c == 0 ? -15 : 16 * c) + wave + 8 * q;
                if (c != 0 || rr <= 15) { const int t = t_s + rr;
                    if (t >= 0) { float ss = 0.f;
#pragma unroll
                        for (int jj = 0; jj < 4; ++jj) ss += (v[q][jj].x * v[q][jj].x + v[q][jj].y * v[q][jj].y) + (v[q][jj].z * v[q][jj].z + v[q][jj].w * v[q][jj].w);
                        const float rstd = 1.0f / sqrtf(wave_sum(ss) * (1.f / D) + EPS);
#pragma unroll
                        for (int jj = 0; jj < 4; ++jj) v[q][jj] = v[q][jj] * rstd * ca[jj] + cb[jj]; }
                    LAS f32x4* dst = (LAS f32x4*)(hs + ((rr + 32) & 31) * D) + lane;
#pragma unroll
                    for (int jj = 0; jj < 4; ++jj) dst[64 * jj] = v[q][jj];
                    if (rr >= 0 && t >= SEQ - 15) { f32x4* o = (f32x4*)(a.out + O_NPP + ((size_t)(j * 8 + cnd) * 15 + (t - (SEQ - 15))) * D) + lane;
#pragma unroll
                        for (int jj = 0; jj < 4; ++jj) o[64 * jj] = v[q][jj]; }
                } }
            __syncthreads();
            if (c < 3) {
#pragma unroll
                for (int q = 0; q < 2; ++q)
#pragma unroll
                    for (int jj = 0; jj < 4; ++jj) v[q][jj] = LDX(xpb, row_s + 16 * (c + 1) + wave + 8 * q, jj); }
            __builtin_amdgcn_sched_barrier(0);
            for (int r = 16 * c; r < 16 * c + 16; ++r) {
                const f32x2 cur = *(const LAS f32x2*)(hs + ((r + 32) & 31) * D + c0);
                if (r == 0) { for (int q = 0; q < w; ++q) S += *(const LAS f32x2*)(hs + ((32 - q) & 31) * D + c0); }
                else S += cur - *(const LAS f32x2*)(hs + ((r - w + 32) & 31) * D + c0);
                const int tt = t_s + r + 1; const int nn = tt < w ? tt : w;
                const f32x2 p = S * (1.0f / (float)nn) - cur;
                *(unsigned*)(H + (size_t)(row_s + r) * D + c0) = cvt_pk_bf16(p.x, p.y);
            }
            __syncthreads();
        }
    }
    const int nlight = bal ? (nA - nC) + (G - nA - nC) : G;
    const int li = bal ? (bx < nC ? -1 : (bx < nA ? bx - nC : (bx >= nA + nC ? bx - (nA + nC) + (nA - nC) : -1))) : G - 1 - bx;
    for (int b = li; b >= 0 && b < NSM; b += nlight) {
        const int cnd = 8 + b; const float* mp = modl + (size_t)cnd * MODW;
        f32x4 v[2][4];
#pragma unroll
        for (int q = 0; q < 2; ++q) { const int i = wave + 8 * q; const float* src = a.in[I_SP] + ((size_t)(j * NSM + b) * 15 + (i < 15 ? i : 0)) * D;
#pragma unroll
            for (int jj = 0; jj < 4; ++jj) v[q][jj] = i < 15 ? *((const f32x4*)src + lane + 64 * jj) : LDX(xsb, b, jj); }
        __builtin_amdgcn_sched_barrier(0);
#pragma unroll
        for (int q = 0; q < 2; ++q) { const int i = wave + 8 * q;
            if (i == 15) { float ss = 0.f;
#pragma unroll
                for (int jj = 0; jj < 4; ++jj) ss += (v[q][jj].x * v[q][jj].x + v[q][jj].y * v[q][jj].y) + (v[q][jj].z * v[q][jj].z + v[q][jj].w * v[q][jj].w);
                const float rstd = 1.0f / sqrtf(wave_sum(ss) * (1.f / D) + EPS);
#pragma unroll
                for (int jj = 0; jj < 4; ++jj) { const f32x4 w4 = *((const f32x4*)wn + lane + 64 * jj), s4 = *((const f32x4*)(mp + D) + lane + 64 * jj), h4 = *((const f32x4*)mp + lane + 64 * jj); v[q][jj] = v[q][jj] * rstd * (w4 * (1.0f + s4)) + h4; } }
            LAS f32x4* dst = (LAS f32x4*)(hs + i * D) + lane;
#pragma unroll
            for (int jj = 0; jj < 4; ++jj) dst[64 * jj] = v[q][jj];
            if (i >= 1) { f32x4* o = (f32x4*)(a.out + O_NPS + ((size_t)(j * NSM + b) * 15 + (i - 1)) * D) + lane;
#pragma unroll
                for (int jj = 0; jj < 4; ++jj) o[64 * jj] = v[q][jj]; } }
        __syncthreads();
        { f32x2 S = (f32x2){0.f, 0.f};
            for (int q = 0; q < w; ++q) S += *(const LAS f32x2*)(hs + (15 - q) * D + c0);
            const f32x2 cur = *(const LAS f32x2*)(hs + 15 * D + c0);
            const f32x2 p = S * (1.0f / (float)w) - cur;
            *(unsigned*)(H + (size_t)(NPR + b) * D + c0) = cvt_pk_bf16(p.x, p.y); }
        __syncthreads();
    }
}
#undef LDX

__device__ __forceinline__ void spatial_phase(AREF a, LAS unsigned char* lds, int j, int gw, int wave, int lane_, int bx, int G) {
    int tid = threadIdx.x; asm volatile("" : "+v"(tid)); const int lane = tid & 63;
    const bf16_t* U = (const bf16_t*)(a.ws + WS_U); const bf16_t* V = (const bf16_t*)(a.ws + WS_V); bf16_t* B2 = (bf16_t*)(a.ws + WS_B2);
    const float* lng = a.in[I_GLG] + (size_t)j * D; const float* lnb = a.in[I_GLB] + (size_t)j * D;
    const float* bs = a.in[I_GBS] + (size_t)j * 8 * 128;
    const bf16_t* WS = (const bf16_t*)(a.ws + WS_WSP) + (size_t)j * 8 * 128 * 128;
    LAS f32x2* st = (LAS f32x2*)lds;
    LAS bf16_t* vt = (LAS bf16_t*)(lds + 1024);
    LAS bf16_t* wa = (LAS bf16_t*)(lds + 1024 + 128 * 136 * 2);
    constexpr int VLD = 136;
    for (int item = bx; item < 256; item += G) {
        const int ch = item >> 1, hq = item & 1, R0 = ch * 128;
        u32x4 w[16][2], wv[4][4];
        const int d8 = (tid & 15) * 8;
#pragma unroll
        for (int rr = 0; rr < 16; ++rr) { const u32x4* vp = (const u32x4*)(V + (size_t)(R0 + wave * 16 + rr) * D) + lane; w[rr][0] = vp[0]; w[rr][1] = vp[64]; }
#pragma unroll
        for (int gi = 0; gi < 4; ++gi)
#pragma unroll
            for (int ii = 0; ii < 4; ++ii) wv[gi][ii] = *(const u32x4*)(V + (size_t)(R0 + (tid >> 4) + 32 * ii) * D + (hq * 4 + gi) * 128 + d8);
        __builtin_amdgcn_sched_barrier(0);
#pragma unroll
        for (int rr = 0; rr < 16; ++rr) { float sm = 0.f, sq = 0.f;
#pragma unroll
            for (int q = 0; q < 2; ++q)
#pragma unroll
                for (int e = 0; e < 4; ++e) { const float lo = bf_lo(w[rr][q][e]), hi = bf_hi(w[rr][q][e]); sm += lo + hi; sq += lo * lo + hi * hi; }
            sm = wave_sum(sm); sq = wave_sum(sq);
            const float mean = sm * (1.f / D), var = sq * (1.f / D) - mean * mean;
            if (lane == 0) st[wave * 16 + rr] = (f32x2){mean, 1.0f / sqrtf((var > 0.f ? var : 0.f) + EPS)}; }
        __syncthreads();
#pragma unroll
        for (int gi = 0; gi < 4; ++gi) {
            const int g = hq * 4 + gi;
            const bf16_t* wsg = WS + (size_t)g * 128 * 128;
            u32x4 wreg[4];
#pragma unroll
            for (int ii = 0; ii < 4; ++ii) wreg[ii] = *(const u32x4*)(wsg + (size_t)((tid >> 4) + 32 * ii) * 128 + d8);
            { const f32x4 ga = *(const f32x4*)(lng + g * 128 + d8), gb = *(const f32x4*)(lng + g * 128 + d8 + 4), ba = *(const f32x4*)(lnb + g * 128 + d8), bb = *(const f32x4*)(lnb + g * 128 + d8 + 4);
#pragma unroll
                for (int ii = 0; ii < 4; ++ii) { const int s = (tid >> 4) + 32 * ii; const u32x4 w = wv[gi][ii]; const f32x2 ms = st[s];
                    u32x4 o;
                    o.x = cvt_pk_bf16((bf_lo(w.x) - ms.x) * ms.y * ga.x + ba.x, (bf_hi(w.x) - ms.x) * ms.y * ga.y + ba.y);
                    o.y = cvt_pk_bf16((bf_lo(w.y) - ms.x) * ms.y * ga.z + ba.z, (bf_hi(w.y) - ms.x) * ms.y * ga.w + ba.w);
                    o.z = cvt_pk_bf16((bf_lo(w.z) - ms.x) * ms.y * gb.x + bb.x, (bf_hi(w.z) - ms.x) * ms.y * gb.y + bb.y);
                    o.w = cvt_pk_bf16((bf_lo(w.w) - ms.x) * ms.y * gb.z + bb.z, (bf_hi(w.w) - ms.x) * ms.y * gb.w + bb.w);
                    *(LAS u32x4*)(vt + s * VLD + d8) = o; }
#pragma unroll
                for (int ii = 0; ii < 4; ++ii) *(LAS u32x4*)(wa + ((tid >> 4) + 32 * ii) * VLD + d8) = wreg[ii]; }
            __syncthreads();
            {
                const int fr = lane & 15, fq = lane >> 4;
                bf16x8 af[8][4]; u32x2 uw[8]; float bt[8];
#pragma unroll
                for (int mb = 0; mb < 8; ++mb) {
#pragma unroll
                    for (int ks = 0; ks < 4; ++ks) if (ks <= (mb >> 1)) af[mb][ks] = *(const LAS bf16x8*)(wa + (mb * 16 + fr) * VLD + ks * 32 + fq * 8);
                    uw[mb] = *(const u32x2*)(U + (size_t)(R0 + mb * 16 + fr) * D + g * 128 + wave * 16 + 4 * fq); bt[mb] = bs[g * 128 + mb * 16 + fr]; }
                bf16x8 bfr[4];
#pragma unroll
                for (int ks = 0; ks < 4; ++ks)
#pragma unroll
                    for (int e = 0; e < 8; ++e) bfr[ks][e] = (short)vt[(ks * 32 + fq * 8 + e) * VLD + wave * 16 + fr];
                __builtin_amdgcn_sched_barrier(0);
#pragma unroll
                for (int mb = 0; mb < 8; ++mb) {
                    f32x4 acc = (f32x4){0.f, 0.f, 0.f, 0.f};
#pragma unroll
                    for (int ks = 0; ks < 4; ++ks) if (ks <= (mb >> 1)) acc = __builtin_amdgcn_mfma_f32_16x16x32_bf16(bfr[ks], af[mb][ks], acc, 0, 0, 0);
                    const size_t off = (size_t)(R0 + mb * 16 + fr) * D + g * 128 + wave * 16 + 4 * fq;
                    u32x2 o; o.x = cvt_pk_bf16(bf_lo(uw[mb].x) * (acc[0] + bt[mb]), bf_hi(uw[mb].x) * (acc[1] + bt[mb])); o.y = cvt_pk_bf16(bf_lo(uw[mb].y) * (acc[2] + bt[mb]), bf_hi(uw[mb].y) * (acc[3] + bt[mb]));
                    *(u32x2*)(B2 + off) = o;
                }
            }
            __syncthreads();
        }
    }
    if (gw < NSM) {
        const int b = gw, row = NPR + b; const u32x4* vp = (const u32x4*)(V + (size_t)row * D) + lane;
        float vv[16]; float sm = 0.f, sq = 0.f;
#pragma unroll
        for (int q = 0; q < 2; ++q) { const u32x4 w = vp[64 * q];
#pragma unroll
            for (int e = 0; e < 4; ++e) { const float lo = bf_lo(w[e]), hi = bf_hi(w[e]); vv[q * 8 + 2 * e] = lo; vv[q * 8 + 2 * e + 1] = hi; sm += lo + hi; sq += lo * lo + hi * hi; } }
        sm = wave_sum(sm); sq = wave_sum(sq);
        const float mean = sm * (1.f / D), var = sq * (1.f / D) - mean * mean, rstd = 1.0f / sqrtf((var > 0.f ? var : 0.f) + EPS);
#pragma unroll
        for (int q = 0; q < 2; ++q) { const int c0 = lane * 8 + 512 * q, g = c0 >> 7;
            const float w00 = a.in[I_GWS][((size_t)(j * 8 + g) * 128) * 128], b0 = bs[g * 128];
            float vn[8], gt[8]; const u32x4 uw = *(const u32x4*)(U + (size_t)row * D + c0);
#pragma unroll
            for (int e = 0; e < 8; ++e) { vn[e] = (vv[q * 8 + e] - mean) * rstd * lng[c0 + e] + lnb[c0 + e]; const float uu = (e & 1) ? bf_hi(uw[e >> 1]) : bf_lo(uw[e >> 1]); gt[e] = uu * (w00 * vn[e] + b0); }
            float* nv = a.out + O_NV + ((size_t)(j * NSM + b)) * D + c0;
            *(f32x4*)nv = (f32x4){vn[0], vn[1], vn[2], vn[3]}; *(f32x4*)(nv + 4) = (f32x4){vn[4], vn[5], vn[6], vn[7]};
            u32x4 o; o.x = cvt_pk_bf16(gt[0], gt[1]); o.y = cvt_pk_bf16(gt[2], gt[3]); o.z = cvt_pk_bf16(gt[4], gt[5]); o.w = cvt_pk_bf16(gt[6], gt[7]);
            *(u32x4*)(B2 + (size_t)row * D + c0) = o; }
    }
}

#define OPQ int G = gridDim.x, bx = blockIdx.x, wave = wave0; asm volatile("" : "+s"(G), "+s"(bx), "+s"(wave)); const int gw = bx * 8 + wave, NGW = G * 8; (void)gw; (void)NGW;
#define GRID_BAR() xcd_barrier(bar)
#define KA (*kargs())
#define WSB(off) ((bf16_t*)(KA.ws + (off)))
#define MODP ((float*)(KA.ws + WS_MOD))
#define RSS(k) ((float*)(KA.ws + WS_RSS) + (size_t)(k) * RSTR)
#define CBG(k) ((float*)(KA.ws + WS_CBG) + (size_t)(k) * NCOND * 2 * FF)
#define CBI(k) ((float*)(KA.ws + WS_CBI) + (size_t)(k) * NCOND * 2 * D)
template <int l>
__device__ __forceinline__ void layer_body(LAS unsigned char* lds, const XcdBarrier& bar, const int wave0) {
    constexpr int j = l >> 1;
    if constexpr ((l & 1) == 0) {
        { OPQ
            int nA = 0;
            if constexpr (l == 0) {
#pragma unroll 1
                for (int k = 0; k < 6; ++k) {
                    const int start = k < 4 ? 22 * k : 88 + 8 * (k - 4), c = (bx - start + 4 * G) % G, N = k < 4 ? 2 * FF : 2 * D;
                    pg8::Gemm g{WSB(WS_SHB) + (size_t)k * 256 * D, k < 4 ? WSB(WS_WGU) + (size_t)k * 2 * FF * D : WSB(WS_WIN) + (size_t)(k - 4) * 2 * D * D, 256, N, D, D, 0};
                    pg8::StaticOrder S; S.init(256, N, G, c);
                    pg8::EpiCbw E{k < 4 ? CBG(k) : CBI(k - 4), N};
                    pg8::gemm_phase<pg8::EpiCbw>(lds, g, S, E);
                }
#pragma unroll 1
                for (int jj = 0; jj < 2; ++jj) {
                    pg8::Gemm g{WSB(WS_WPO) + (size_t)jj * D * D, WSB(WS_WPG) + (size_t)jj * 4 * 65536, D, D, 256, D, 256};
                    pg8::StaticOrder S; S.init(D, D, G, (bx - 104 - 16 * jj + 4 * G) % G);
                    pg8::EpiBf16 E{WSB(WS_WEF) + (size_t)jj * D * D, WSB(WS_WEF) + (size_t)jj * D * D, nullptr, nullptr, nullptr, 0};
                    pg8::gemm_phase<pg8::EpiBf16>(lds, g, S, E);
                }
                nA = G < 136 ? G : 136;
            }
            pool_pre_phase(KA, lds, MODP + (size_t)l * 6 * D, l, j, wave, 0, bx, G, nA, l == 0 ? 104 : 0);
        }
        GRID_BAR();
        { OPQ
            pg8::Gemm g{WSB(WS_H), WSB(WS_WEF) + (size_t)j * D * D, NPR, D, D, D, 0}; pg8::StaticOrder S; S.init(NPR, D, G, bx);
            pg8::EpiResidT<true> E{l == 0 ? KA.in[I_XP] : nullptr, WSB(WS_XB), WSB(WS_XB), MODP + (size_t)l * 6 * D + 2 * D, WSB(WS_B2), KA.in[I_NFFN] + (size_t)l * D, MODP + (size_t)l * 6 * D + 4 * D, RSS(l)};
            pg8::gemm_phase<pg8::EpiResidT<true>>(lds, g, S, E);
            skinny_phase<0, 2, 4>(lds, Skinny{WSB(WS_H), D, 0, WSB(WS_WEF) + (size_t)j * D * D, D, D / 16, 0, G, bx},
                SkResid{l == 0 ? KA.in[I_XS] : nullptr, WSB(WS_XB), WSB(WS_XB), MODP + (size_t)l * 6 * D + 2 * D, WSB(WS_B2), KA.in[I_NFFN] + (size_t)l * D, MODP + (size_t)l * 6 * D + 4 * D, RSS(l)});
        }
        GRID_BAR();
    } else {
        { OPQ
            pg8::Gemm g{WSB(WS_H), WSB(WS_WIN) + (size_t)j * 2 * D * D, NPR, 2 * D, D, D, 0}; pg8::StaticOrder S; S.init(NPR, 2 * D, G, bx);
            pg8::EpiBf16 E{WSB(WS_U), WSB(WS_V), nullptr, RSS(4 + j), CBI(j), 2 * D};
            pg8::gemm_phase<pg8::EpiBf16>(lds, g, S, E);
            skinny_phase<0, 4, 4>(lds, Skinny{WSB(WS_H), D, 0, WSB(WS_WIN) + (size_t)j * 2 * D * D, D, 2 * D / 16, 0, G, bx}, SkBf16{WSB(WS_U), WSB(WS_V), nullptr, RSS(4 + j), CBI(j), 2 * D});
        }
        GRID_BAR();
        { OPQ spatial_phase(KA, lds, j, gw, wave, 0, bx, G); }
        GRID_BAR();
        { OPQ
            pg8::Gemm g{WSB(WS_B2), WSB(WS_WGO) + (size_t)j * D * D, NPR, D, D, D, 0}; pg8::StaticOrder S; S.init(NPR, D, G, bx);
            pg8::EpiResidT<true> E{nullptr, WSB(WS_XB), WSB(WS_XB), MODP + (size_t)l * 6 * D + 2 * D, WSB(WS_H), KA.in[I_NFFN] + (size_t)l * D, MODP + (size_t)l * 6 * D + 4 * D, RSS(l)};
            pg8::gemm_phase<pg8::EpiResidT<true>>(lds, g, S, E);
            skinny_phase<0, 2, 4>(lds, Skinny{WSB(WS_B2), D, 0, WSB(WS_WGO) + (size_t)j * D * D, D, D / 16, 0, G, bx},
                SkResid{nullptr, WSB(WS_XB), WSB(WS_XB), MODP + (size_t)l * 6 * D + 2 * D, WSB(WS_H), KA.in[I_NFFN] + (size_t)l * D, MODP + (size_t)l * 6 * D + 4 * D, RSS(l)});
        }
        GRID_BAR();
    }
    { OPQ
        pg8::Gemm g{WSB((l & 1) ? WS_H : WS_B2), WSB(WS_WGU) + (size_t)l * 2 * FF * D, NPR, 2 * FF, D, D, 0}; pg8::StaticOrder S; S.init(NPR, 2 * FF, G, bx);
        pg8::stage_swiglu_tables(lds, S, RSS(l), CBG(l));
        pg8::EpiSwiGLU E{WSB(WS_ACT), lds};
        pg8::gemm_phase<pg8::EpiSwiGLU>(lds, g, S, E);
        { const int extra = S.nwg % G; skinny_phase<2, 8, 2>(lds, Skinny{WSB((l & 1) ? WS_H : WS_B2), D, 0, WSB(WS_WGU) + (size_t)l * 2 * FF * D, D, FF / 16, extra, G - extra, bx}, SkSwiGLU{WSB(WS_ACT), RSS(l), CBG(l)}); }
    }
    GRID_BAR();
    { OPQ
        pg8::Gemm g{WSB(WS_ACT), WSB(WS_WDN) + (size_t)l * D * FF, NPR, D, FF, FF, 0}; pg8::StaticOrder S; S.init(NPR, D, G, bx);
        if constexpr ((l & 1) == 0) {
            pg8::EpiResidT<true> E{nullptr, WSB(WS_XB), WSB(WS_XB), MODP + (size_t)l * 6 * D + 5 * D, WSB(WS_H), KA.in[I_NMIX] + (size_t)(l + 1) * D, MODP + (size_t)(l + 1) * 6 * D + 1 * D, RSS(4 + j)};
            pg8::gemm_phase<pg8::EpiResidT<true>>(lds, g, S, E);
            skinny_phase<0, 2, 11>(lds, Skinny{WSB(WS_ACT), FF, 0, WSB(WS_WDN) + (size_t)l * D * FF, FF, D / 16, 0, G, bx},
                SkResid{nullptr, WSB(WS_XB), WSB(WS_XB), MODP + (size_t)l * 6 * D + 5 * D, WSB(WS_H), KA.in[I_NMIX] + (size_t)(l + 1) * D, MODP + (size_t)(l + 1) * 6 * D + 1 * D, RSS(4 + j)});
        } else {
            pg8::EpiResidT<false> E{nullptr, WSB(WS_XB), WSB(WS_XB), MODP + (size_t)l * 6 * D + 5 * D, nullptr, nullptr, nullptr, nullptr};
            pg8::gemm_phase<pg8::EpiResidT<false>>(lds, g, S, E);
            skinny_phase<0, 2, 11>(lds, Skinny{WSB(WS_ACT), FF, 0, WSB(WS_WDN) + (size_t)l * D * FF, FF, D / 16, 0, G, bx},
                SkResid{nullptr, WSB(WS_XB), WSB(WS_XB), MODP + (size_t)l * 6 * D + 5 * D, nullptr, nullptr, nullptr, nullptr});
        }
    }
    GRID_BAR();
}

__global__ void __launch_bounds__(512) mega_fwd(Args a_unused) {
    extern __shared__ __attribute__((aligned(16))) unsigned char lds_raw[];
    LAS unsigned char* lds = (LAS unsigned char*)lds_raw;
    cg::grid_group grid = cg::this_grid();
    const int wave0 = __builtin_amdgcn_readfirstlane((int)threadIdx.x >> 6);
    volatile LAS unsigned* MISC = (volatile LAS unsigned*)(lds + 131072 + 320);
    if (threadIdx.x < 32) MISC[threadIdx.x] = 0u;
    __syncthreads();
    const XcdBarrier bar = xcd_barrier_post((unsigned*)kargs()->ws, MISC + 8);
    if (kargs()->ws == nullptr) grid.sync();

    { OPQ prologue1_phase(KA, lds, gw, NGW, wave, (int)threadIdx.x & 63); }
    GRID_BAR();
    { OPQ
        pg8::Gemm g{WSB(WS_SC), WSB(WS_WADA), 256, MODW, D, D, 0}; pg8::StaticOrder S; S.init(256, MODW, G, bx);
        pg8::EpiAda E{MODP, KA.in[I_BADA], WSB(WS_SHB)};
        pg8::gemm_phase<pg8::EpiAda>(lds, g, S, E);
        prologue2_phase(KA, lds, wave, (int)threadIdx.x & 63, bx, G);
    }
    GRID_BAR();
    layer_body<0>(lds, bar, wave0); layer_body<1>(lds, bar, wave0); layer_body<2>(lds, bar, wave0); layer_body<3>(lds, bar, wave0);
    { OPQ final_phase(WSB(WS_XB), KA.out, KA.in[I_NFIN], gw, NGW, (int)threadIdx.x & 63); }
}

extern "C" void kernel_launch(void* const* d_in, const int* in_sizes, int n_in, void* d_out, int out_size, void* d_ws, size_t ws_size, hipStream_t stream) {
    static int grid = 0;
    if (grid == 0) {
        if (n_in != 22 || ws_size < WS_END) { fprintf(stderr, "kernel_launch: expected 22 inputs and >= %zu bytes of workspace; got %d, %zu\n", (size_t)WS_END, n_in, ws_size); grid = -1; return; }
        int dev = 0, cus = 0, per_cu = 0;
        hipGetDevice(&dev); hipDeviceGetAttribute(&cus, hipDeviceAttributeMultiprocessorCount, dev);
        if (hipFuncSetAttribute((const void*)mega_fwd, hipFuncAttributeMaxDynamicSharedMemorySize, LDS_BYTES) != hipSuccess) { fprintf(stderr, "kernel_launch: hipFuncSetAttribute failed\n"); grid = -1; return; }
        if (hipOccupancyMaxActiveBlocksPerMultiprocessor(&per_cu, (const void*)mega_fwd, 512, LDS_BYTES) != hipSuccess || per_cu < 1) { fprintf(stderr, "kernel_launch: occupancy query says %d\n", per_cu); per_cu = 1; }
        (void)hipGetLastError();
        grid = cus * per_cu;
    }
    if (grid < 0) return;
    Args a{};
    for (int i = 0; i < 22; ++i) a.in[i] = (const float*)d_in[i];
    a.out = (float*)d_out; a.ws = (unsigned char*)d_ws;
    void* args[] = {&a};
    if (hipMemsetAsync(d_ws, 0, 65536, stream) != hipSuccess) { fprintf(stderr, "kernel_launch: memset of barrier words failed\n"); return; }
    hipError_t e = hipLaunchCooperativeKernel((const void*)mega_fwd, dim3(grid), dim3(512), args, LDS_BYTES, stream);
    if (e != hipSuccess) fprintf(stderr, "cooperative launch failed: %s (grid %d)\n", hipGetErrorString(e), grid);
}
```
